# Optimizing an MI355X kernel written in HIP

```python
import jax, jax.numpy as jnp
from jax import lax
import numpy as np

D_MODEL = 1024
BATCH = 16
SEQ = 2048
DEPTH = 2
DEC_BATCH = 4
DEC_SEQ = 8192
PAST_LEN = 128

FFN_DIM = 2816
SGU_DIM = 3 * D_MODEL
SGU_GROUPS = 8
SGU_CHUNK = 128
HGRN_DK = 128
HGRN_HEADS = D_MODEL // HGRN_DK
HGRN_DV = D_MODEL // HGRN_HEADS
HGRN_HK = HGRN_HEADS * HGRN_DK
HGRN_HV = HGRN_HEADS * HGRN_DV
HGRN_CHUNK = 64
N_SGU_LAYERS = (DEPTH + 1) // 2
N_HGRN_LAYERS = DEPTH // 2
EPS = 1e-6

kernel_name = 'hybrid_sgu_hgrn2_macaron_encoder'


def _rmsnorm(x, w):
    xf = x.astype(jnp.float32)
    y = xf * lax.rsqrt(jnp.mean(xf * xf, axis=-1, keepdims=True) + EPS)
    return (y * w.astype(jnp.float32)).astype(x.dtype)


def _layernorm(x, g, b):
    xf = x.astype(jnp.float32)
    mu = jnp.mean(xf, axis=-1, keepdims=True)
    xc = xf - mu
    y = xc * lax.rsqrt(jnp.mean(xc * xc, axis=-1, keepdims=True) + EPS)
    return (y * g.astype(jnp.float32) + b.astype(jnp.float32)).astype(x.dtype)


def _swiglu(h, wg, wu, wd):
    return (jax.nn.silu(h @ wg) * (h @ wu)) @ wd


def _spatial_gating(h, w_in, ln_g, ln_b, w_s, b_s, w_out):
    B, L, _ = h.shape
    z = jax.nn.gelu(h @ w_in, approximate=False)
    u, v = jnp.split(z, 2, axis=-1)
    v = _layernorm(v, ln_g, ln_b)
    v = v.reshape(B, L // SGU_CHUNK, SGU_CHUNK, SGU_GROUPS, SGU_DIM // SGU_GROUPS)
    s = jnp.einsum('gts,bnsge->bntge', w_s, v) + b_s.T[None, None, :, :, None]
    return (u * s.reshape(B, L, SGU_DIM)) @ w_out


def _gla_scan(q, k, v, g):
    B, L, H, DK = q.shape
    DV = v.shape[-1]
    n = L // HGRN_CHUNK

    def to_chunks(t):
        return t.reshape(B, n, HGRN_CHUNK, H, t.shape[-1]).transpose(1, 0, 3, 2, 4)

    mask = jnp.tril(jnp.ones((HGRN_CHUNK, HGRN_CHUNK), dtype=bool))[:, :, None]

    def step(S, inp):
        qc, kc, vc, gc = inp
        b = jnp.cumsum(gc, axis=2)
        diff = b[:, :, :, None, :] - b[:, :, None, :, :]
        decay = jnp.exp(jnp.where(mask, diff, -jnp.inf))
        a = jnp.einsum('bhtsk,bhsk->bhts', qc[:, :, :, None, :] * decay, kc)
        o = jnp.einsum('bhts,bhsv->bhtv', a, vc) + jnp.einsum('bhtk,bhkv->bhtv', qc * jnp.exp(b), S)
        b_last = b[:, :, -1:, :]
        S = jnp.exp(b_last)[:, :, 0, :, None] * S + jnp.einsum('bhsk,bhsv->bhkv', kc * jnp.exp(b_last - b), vc)
        return S, o

    S0 = jnp.zeros((B, H, DK, DV), jnp.float32)
    _, o = lax.scan(step, S0, (to_chunks(q), to_chunks(k), to_chunks(v), to_chunks(g)))
    return o.transpose(1, 0, 3, 2, 4).reshape(B, L, H, DV)


def _hgrn2(h, w_in, lb_f, lb_b, norm_w, w_out):
    B, L, _ = h.shape
    proj = (h @ w_in).astype(jnp.float32)
    q, ff, fb, i, g = jnp.split(proj, [HGRN_HK, 2 * HGRN_HK, 3 * HGRN_HK, 3 * HGRN_HK + HGRN_HV], axis=-1)

    def heads(t):
        return t.reshape(B, L, HGRN_HEADS, -1)

    def gates(logit, lb):
        f = lb + (1.0 - lb) * jax.nn.sigmoid(logit)
        return heads(1.0 - f), heads(jnp.log(f))

    q = heads(jax.nn.silu(q))
    i = heads(i)
    kf, gf = gates(ff, lb_f)
    kb, gb = gates(fb, lb_b)
    o_f = _gla_scan(q, kf, i, gf)
    o_b = jnp.flip(_gla_scan(jnp.flip(q, 1), jnp.flip(kb, 1), jnp.flip(i, 1), jnp.flip(gb, 1)), 1)
    o = o_f + o_b
    o = o * lax.rsqrt(jnp.mean(o * o, axis=-1, keepdims=True) + EPS)
    o = o.reshape(B, L, HGRN_HV) * norm_w.astype(jnp.float32) * jax.nn.silu(g)
    return o.astype(h.dtype) @ w_out


def _trunk(x, norm_w, ffn_gate, ffn_up, ffn_down, sgu_w_in, sgu_ln_g, sgu_ln_b, sgu_w_s, sgu_b_s,
           sgu_w_out, hgrn_w_in, lb, hgrn_norm_w, hgrn_w_out, final_norm):
    for layer in range(DEPTH):
        x = x + 0.5 * _swiglu(_rmsnorm(x, norm_w[layer, 0]), ffn_gate[layer, 0], ffn_up[layer, 0], ffn_down[layer, 0])
        h = _rmsnorm(x, norm_w[layer, 1])
        j = layer // 2
        if layer % 2 == 0:
            x = x + _spatial_gating(h, sgu_w_in[j], sgu_ln_g[j], sgu_ln_b[j], sgu_w_s[j], sgu_b_s[j], sgu_w_out[j])
        else:
            x = x + _hgrn2(h, hgrn_w_in[j], lb[0, layer], lb[1, layer], hgrn_norm_w[j], hgrn_w_out[j])
        x = x + 0.5 * _swiglu(_rmsnorm(x, norm_w[layer, 2]), ffn_gate[layer, 1], ffn_up[layer, 1], ffn_down[layer, 1])
    return _rmsnorm(x, final_norm)


def setup_inputs(seed: int = 0) -> dict:
    key = jax.random.key(seed)
    ks = jax.random.split(key, 20)
    nrm = jax.random.normal
    D, F = D_MODEL, FFN_DIM
    return {
        'x_prompt': nrm(ks[0], (BATCH, SEQ, D), jnp.float32),
        'x_sample': nrm(ks[1], (DEC_BATCH, DEC_SEQ, D), jnp.float32),
        'norm_w': 1.0 + 0.02 * nrm(ks[2], (DEPTH, 3, D), jnp.float32),
        'ffn_gate': nrm(ks[3], (DEPTH, 2, D, F), jnp.float32) * D ** -0.5,
        'ffn_up': nrm(ks[4], (DEPTH, 2, D, F), jnp.float32) * D ** -0.5,
        'ffn_down': nrm(ks[5], (DEPTH, 2, F, D), jnp.float32) * F ** -0.5,
        'sgu_w_in': nrm(ks[6], (N_SGU_LAYERS, D, 2 * SGU_DIM), jnp.float32) * D ** -0.5,
        'sgu_ln_g': 1.0 + 0.02 * nrm(ks[7], (N_SGU_LAYERS, SGU_DIM), jnp.float32),
        'sgu_ln_b': 0.02 * nrm(ks[8], (N_SGU_LAYERS, SGU_DIM), jnp.float32),
        'sgu_w_s': nrm(ks[9], (N_SGU_LAYERS, SGU_GROUPS, SGU_CHUNK, SGU_CHUNK), jnp.float32) * SGU_CHUNK ** -0.5,
        'sgu_b_s': 1.0 + 0.02 * nrm(ks[10], (N_SGU_LAYERS, SGU_GROUPS, SGU_CHUNK), jnp.float32),
        'sgu_w_out': nrm(ks[11], (N_SGU_LAYERS, SGU_DIM, D), jnp.float32) * SGU_DIM ** -0.5,
        'hgrn_w_in': nrm(ks[12], (N_HGRN_LAYERS, D, 3 * HGRN_HK + 2 * HGRN_HV), jnp.float32) * D ** -0.5,
        'hgrn_lb_raw': 0.1 * nrm(ks[13], (2, DEPTH, HGRN_HK), jnp.float32),
        'hgrn_norm_w': 1.0 + 0.02 * nrm(ks[14], (N_HGRN_LAYERS, HGRN_HV), jnp.float32),
        'hgrn_w_out': nrm(ks[15], (N_HGRN_LAYERS, HGRN_HV, D), jnp.float32) * HGRN_HV ** -0.5,
        'final_norm': 1.0 + 0.02 * nrm(ks[16], (D,), jnp.float32),
    }


def reference(x_prompt, x_sample, norm_w, ffn_gate, ffn_up, ffn_down, sgu_w_in, sgu_ln_g, sgu_ln_b,
              sgu_w_s, sgu_b_s, sgu_w_out, hgrn_w_in, hgrn_lb_raw, hgrn_norm_w, hgrn_w_out, final_norm):
    p = jax.nn.softmax(hgrn_lb_raw.astype(jnp.float32), axis=1)
    lb = jnp.cumsum(p, axis=1) - p[:, :1]
    y_prompt = _trunk(x_prompt, norm_w, ffn_gate, ffn_up, ffn_down, sgu_w_in, sgu_ln_g, sgu_ln_b, sgu_w_s,
                      sgu_b_s, sgu_w_out, hgrn_w_in, lb, hgrn_norm_w, hgrn_w_out, final_norm)
    y_sample = _trunk(x_sample, norm_w, ffn_gate, ffn_up, ffn_down, sgu_w_in, sgu_ln_g, sgu_ln_b, sgu_w_s,
                      sgu_b_s, sgu_w_out, hgrn_w_in, lb, hgrn_norm_w, hgrn_w_out, final_norm)
    return (y_prompt, y_sample)
```

```cpp
#include <hip/hip_runtime.h>
#include <hip/hip_cooperative_groups.h>
#include <cstdio>
#include <cstdint>
namespace cg = cooperative_groups;
namespace pg8 {
#define PG8_LAS __attribute__((address_space(3)))
typedef unsigned short bf16_t;
typedef short bf16x8 __attribute__((ext_vector_type(8)));
typedef float f32x4 __attribute__((ext_vector_type(4)));
typedef unsigned u32x4 __attribute__((ext_vector_type(4)));
constexpr int BM = 256, BK = 64, HALF = 128, HTB = HALF * BK * 2  , STAGE_BYTES = 8 * HTB, NXCD = 8, WGM = 8;

__host__ __device__ __forceinline__ int lds_byte(int r, int c) { const int st = (r >> 4) * 2 + (c >> 5), rr = r & 15, cc = c & 31, ob = rr * 64 + cc * 2; return st * 1024 + (ob ^ (((ob >> 9) & 1) << 5)); }
__host__ __device__ __forceinline__ void stage_rc(int b, int& R, int& C) { const int st = b / 1024, sb = b % 1024, swz = sb ^ (((sb >> 9) & 1) << 5); R = (st >> 1) * 16 + swz / 64; C = (st & 1) * 32 + (swz % 64) / 2; }
__host__ __device__ __forceinline__ int perm32(int rho) { const int n = rho >> 4, i = rho & 15; return 8 * (i >> 2) + 4 * n + (i & 3); }

struct Unit { int pm, pn; };
struct Gemm { const bf16_t* A; const bf16_t* Bt; int M, N, K; };

struct StaticOrder {
    int nM, nN, nwg, G, c;
    __host__ __device__ void init(int M, int N, int G_, int c_) { nM = M / BM; nN = N / BM; nwg = nM * nN; G = G_; c = c_; }
    __host__ __device__ bool next(int i, Unit& u) const {
        const long L = (long)i * G + c; if (L >= nwg) return false;
        int wgid = (int)L; { const int q = nwg / NXCD, r = nwg % NXCD, xcd = wgid % NXCD, off = wgid / NXCD; wgid = (xcd < r ? xcd * (q + 1) : r * (q + 1) + (xcd - r) * q) + off; }
        const int nig = WGM * nN, gid = wgid / nig, fm = gid * WGM, gsz = (nM - fm) < WGM ? (nM - fm) : WGM;
        u.pm = fm + ((wgid % nig) % gsz); u.pn = (wgid % nig) / gsz; return true;
    }
    __device__ __forceinline__ void a_ready(const Unit&) const {}
    __device__ __forceinline__ void done(const Unit&) const {}
};


typedef float f32x2 __attribute__((ext_vector_type(2)));
typedef __bf16 bf16x2_t __attribute__((ext_vector_type(2)));
__device__ __forceinline__ unsigned cvt_pk_bf16(float lo, float hi) { const f32x2 f = {lo, hi}; const bf16x2_t v = __builtin_convertvector(f, bf16x2_t); return __builtin_bit_cast(unsigned, v); }
typedef unsigned u32x2 __attribute__((ext_vector_type(2)));
__device__ __forceinline__ f32x2 gelu_pk(f32x2 v) {
    const f32x2 av = __builtin_elementwise_abs(v), d = av * 0.2316418882f + 1.0f;
    f32x2 t; t.x = __builtin_amdgcn_rcpf(d.x); t.y = __builtin_amdgcn_rcpf(d.y);
    f32x2 q = t * 0.5307027145f + (-0.7265760135f); q = q * t + 0.7107068705f; q = q * t + (-0.142248368f); q = q * t + 0.127414796f; q = q * t;
    const f32x2 s = (v * v) * (-0.72134752044f);
    f32x2 e; e.x = __builtin_amdgcn_exp2f(s.x); e.y = __builtin_amdgcn_exp2f(s.y);
    const f32x2 m = v * (q * e), r = v - m;
    f32x2 o; o.x = v.x < 0.f ? m.x : r.x; o.y = v.y < 0.f ? m.y : r.y; return o;
}
__device__ __forceinline__ f32x4 gelu4(f32x4 v) { const f32x2 a = gelu_pk((f32x2){v[0], v[1]}), b = gelu_pk((f32x2){v[2], v[3]}); return (f32x4){a.x, a.y, b.x, b.y}; }
__device__ __forceinline__ float silu1(float x) { return x * __builtin_amdgcn_rcpf(1.0f + __expf(-x)); }
__device__ __forceinline__ f32x4 silu4(f32x4 v) { return (f32x4){silu1(v[0]), silu1(v[1]), silu1(v[2]), silu1(v[3])}; }
__device__ __forceinline__ float bf2f(unsigned short b) { return __uint_as_float(((unsigned)b) << 16); }
__device__ __forceinline__ float bflo(unsigned w) { return __uint_as_float(w << 16); }
__device__ __forceinline__ float bfhi(unsigned w) { return __uint_as_float(w & 0xffff0000u); }
__device__ __forceinline__ float row_rstd(const float* ssq, int row) {
    const f32x4* p = (const f32x4*)(ssq + (size_t)row * 16);
    const f32x4 a = p[0], b = p[1], c = p[2], d = p[3];
    const float s = ((a[0] + a[1]) + (a[2] + a[3])) + ((b[0] + b[1]) + (b[2] + b[3])) + ((c[0] + c[1]) + (c[2] + c[3])) + ((d[0] + d[1]) + (d[2] + d[3]));
    return rsqrtf(s * (1.0f / 1024.0f) + 1e-6f);
}

struct EpiSwiGLU {
    static constexpr bool PERM = true, AFTER_DRAIN = false;
    bf16_t* H; int ldh; const float* ssq;
    __device__ __forceinline__ void operator()(const f32x4 (&acc)[2][2][4][2], const Unit& u, int wr, int wc, int fr, int fq) const {
        const int row0 = u.pm * BM + wr * 64 + fr, col0 = u.pn * HALF + wc * 32 + 8 * fq;
#pragma unroll
        for (int ai = 0; ai < 2; ++ai)
#pragma unroll
            for (int m = 0; m < 4; ++m) { const int row = row0 + ai * HALF + m * 16; const float rs = row_rstd(ssq, row);
                const f32x4 g0 = acc[ai][0][m][0] * rs, g1 = acc[ai][0][m][1] * rs, u0 = acc[ai][1][m][0] * rs, u1 = acc[ai][1][m][1] * rs;
                const f32x4 h0 = silu4(g0) * u0, h1 = silu4(g1) * u1;
                u32x4 w; w.x = cvt_pk_bf16(h0[0], h0[1]); w.y = cvt_pk_bf16(h0[2], h0[3]); w.z = cvt_pk_bf16(h1[0], h1[1]); w.w = cvt_pk_bf16(h1[2], h1[3]);
                *(u32x4*)(H + (size_t)row * ldh + col0) = w; asm volatile("" ::: "memory"); }
    }
};
struct EpiDown {
    static constexpr bool PERM = false, AFTER_DRAIN = false;
    const float* res; float* out; bf16_t* xb; float* ssq; float scale;
    __device__ __forceinline__ void operator()(const f32x4 (&acc)[2][2][4][2], const Unit& u, int wr, int wc, int fr, int fq) const {
        const int row0 = u.pm * BM + wr * 64 + fr, col0 = u.pn * BM + wc * 32 + 4 * fq;
#pragma unroll
        for (int ai = 0; ai < 2; ++ai)
#pragma unroll
            for (int m = 0; m < 4; ++m) { const int row = row0 + ai * HALF + m * 16; const size_t off = (size_t)row * 1024 + col0; float s2 = 0.f;
#pragma unroll
                for (int bj = 0; bj < 2; ++bj)
#pragma unroll
                    for (int n = 0; n < 2; ++n) { const f32x4 r = *(const f32x4*)(res + off + bj * HALF + n * 16); const f32x4 v = r + acc[ai][bj][m][n] * scale;
                        *(f32x4*)(out + off + bj * HALF + n * 16) = v; u32x2 w; w.x = cvt_pk_bf16(v[0], v[1]); w.y = cvt_pk_bf16(v[2], v[3]);
                        *(u32x2*)(xb + off + bj * HALF + n * 16) = w; s2 += (v[0] * v[0] + v[1] * v[1]) + (v[2] * v[2] + v[3] * v[3]); }
                s2 += __shfl_xor(s2, 16); s2 += __shfl_xor(s2, 32);
                if (fq == 0) ssq[(size_t)row * 16 + u.pn * 4 + wc] = s2;
                asm volatile("" ::: "memory"); }
    }
};
struct EpiSguV {
    static constexpr bool PERM = true, AFTER_DRAIN = false;
    bf16_t* VS; const float* ssq; f32x2* stats;
    __device__ __forceinline__ void operator()(const f32x4 (&acc)[2][2][4][2], const Unit& u, int wr, int wc, int fr, int fq) const {
        const int row0 = u.pm * BM + wr * 64 + fr, col0 = u.pn * BM + wc * 32 + 8 * fq;
#pragma unroll
        for (int ai = 0; ai < 2; ++ai)
#pragma unroll
            for (int m = 0; m < 4; ++m) { const int row = row0 + ai * HALF + m * 16; const float rs = row_rstd(ssq, row); float s1 = 0.f, s2 = 0.f;
#pragma unroll
                for (int bj = 0; bj < 2; ++bj) { const f32x4 v0 = gelu4(acc[ai][bj][m][0] * rs), v1 = gelu4(acc[ai][bj][m][1] * rs);
                    s1 += ((v0[0] + v0[1]) + (v0[2] + v0[3])) + ((v1[0] + v1[1]) + (v1[2] + v1[3]));
                    s2 += ((v0[0] * v0[0] + v0[1] * v0[1]) + (v0[2] * v0[2] + v0[3] * v0[3])) + ((v1[0] * v1[0] + v1[1] * v1[1]) + (v1[2] * v1[2] + v1[3] * v1[3]));
                    u32x4 w; w.x = cvt_pk_bf16(v0[0], v0[1]); w.y = cvt_pk_bf16(v0[2], v0[3]); w.z = cvt_pk_bf16(v1[0], v1[1]); w.w = cvt_pk_bf16(v1[2], v1[3]);
                    *(u32x4*)(VS + (size_t)row * 3072 + col0 + bj * HALF) = w; }
                s1 += __shfl_xor(s1, 16); s1 += __shfl_xor(s1, 32); s2 += __shfl_xor(s2, 16); s2 += __shfl_xor(s2, 32);
                if (fq == 0) stats[(size_t)row * 48 + u.pn * 4 + wc] = (f32x2){s1, s2}; asm volatile("" ::: "memory"); }
    }
};
struct EpiSguU {
    static constexpr bool PERM = true, AFTER_DRAIN = false;
    bf16_t* VS; const float* ssq;
    __device__ __forceinline__ void operator()(const f32x4 (&acc)[2][2][4][2], const Unit& u, int wr, int wc, int fr, int fq) const {
        const int row0 = u.pm * BM + wr * 64 + fr, col0 = u.pn * BM + wc * 32 + 8 * fq;
#pragma unroll
        for (int ai = 0; ai < 2; ++ai)
#pragma unroll
            for (int m = 0; m < 4; ++m) { const int row = row0 + ai * HALF + m * 16; const float rs = row_rstd(ssq, row);
#pragma unroll
                for (int bj = 0; bj < 2; ++bj) { u32x4* p = (u32x4*)(VS + (size_t)row * 3072 + col0 + bj * HALF); const u32x4 sv = *p;
                    const f32x4 v0 = gelu4(acc[ai][bj][m][0] * rs), v1 = gelu4(acc[ai][bj][m][1] * rs);
                    u32x4 w; w.x = cvt_pk_bf16(v0[0] * bflo(sv.x), v0[1] * bfhi(sv.x)); w.y = cvt_pk_bf16(v0[2] * bflo(sv.y), v0[3] * bfhi(sv.y));
                    w.z = cvt_pk_bf16(v1[0] * bflo(sv.z), v1[1] * bfhi(sv.z)); w.w = cvt_pk_bf16(v1[2] * bflo(sv.w), v1[3] * bfhi(sv.w));
                    *p = w; } asm volatile("" ::: "memory"); }
    }
};
__device__ __forceinline__ unsigned pk_f16(float a, float b) { const _Float16 ha = (_Float16)a, hb = (_Float16)b; return (unsigned)__builtin_bit_cast(unsigned short, ha) | ((unsigned)__builtin_bit_cast(unsigned short, hb) << 16); }
struct EpiHgrn {
    static constexpr bool PERM = true, AFTER_DRAIN = false;
    bf16_t* O; size_t stride; const float* ssq; const float* lb;
    __device__ __forceinline__ void operator()(const f32x4 (&acc)[2][2][4][2], const Unit& u, int wr, int wc, int fr, int fq) const {
        const int region = u.pn >> 2; const int row0 = u.pm * BM + wr * 64 + fr, col0 = (u.pn & 3) * BM + wc * 32 + 8 * fq;
        bf16_t* base = O + (size_t)region * stride;
        f32x4 l0[2], l1[2];
        if (region == 1 || region == 2) {
#pragma unroll
            for (int bj = 0; bj < 2; ++bj) { l0[bj] = *(const f32x4*)(lb + (region - 1) * 1024 + col0 + bj * HALF); l1[bj] = *(const f32x4*)(lb + (region - 1) * 1024 + col0 + bj * HALF + 4); }
        } else { l0[0] = l0[1] = l1[0] = l1[1] = (f32x4){0.f, 0.f, 0.f, 0.f}; }
#pragma unroll
        for (int ai = 0; ai < 2; ++ai)
#pragma unroll
            for (int m = 0; m < 4; ++m) { const int row = row0 + ai * HALF + m * 16; const float rs = row_rstd(ssq, row);
#pragma unroll
                for (int bj = 0; bj < 2; ++bj) { f32x4 v0 = acc[ai][bj][m][0] * rs, v1 = acc[ai][bj][m][1] * rs; u32x4 w;
                    if (region == 1 || region == 2) {
#pragma unroll
                        for (int j = 0; j < 4; ++j) { const float sg0 = __builtin_amdgcn_rcpf(1.0f + __expf(-v0[j])), sg1 = __builtin_amdgcn_rcpf(1.0f + __expf(-v1[j]));
                            v0[j] = __logf(l0[bj][j] + (1.0f - l0[bj][j]) * sg0); v1[j] = __logf(l1[bj][j] + (1.0f - l1[bj][j]) * sg1); }
                        w.x = pk_f16(v0[0], v0[1]); w.y = pk_f16(v0[2], v0[3]); w.z = pk_f16(v1[0], v1[1]); w.w = pk_f16(v1[2], v1[3]);
                    } else {
                        if (region != 3) { v0 = silu4(v0); v1 = silu4(v1); }
                        w.x = cvt_pk_bf16(v0[0], v0[1]); w.y = cvt_pk_bf16(v0[2], v0[3]); w.z = cvt_pk_bf16(v1[0], v1[1]); w.w = cvt_pk_bf16(v1[2], v1[3]);
                    }
                    *(u32x4*)(base + (size_t)row * 1024 + col0 + bj * HALF) = w; } asm volatile("" ::: "memory"); }
    }
};

template <class Epi, class Sched, bool ALIGN_EPI = false, bool SP2 = false>
__device__ __forceinline__ void gemm_phase(PG8_LAS unsigned char* lds, const Gemm g, const Sched& S, const Epi& E) {
    int tid_ = threadIdx.x; asm volatile("" : "+v"(tid_));
    const int tid = tid_, wid = __builtin_amdgcn_readfirstlane(tid >> 6), lane = tid & 63, wr = wid >> 2, wc = wid & 3, fr = lane & 15, fq = lane >> 4;
    const int K = g.K, nt = K / BK;
    unsigned voffA[2], voffB[2];
#pragma unroll
    for (int i = 0; i < 2; ++i) { int R, C; stage_rc(tid * 16 + i * 8192, R, C); const int Rb = Epi::PERM ? ((R & ~31) + perm32(R & 31)) : R;
        voffA[i] = (unsigned)(R * K + C) * 2u; voffB[i] = (unsigned)(Rb * K + C) * 2u; }
    const size_t kstep = (size_t)(BK * 2);
    const size_t hstep = (size_t)HALF * K * 2;
    const size_t tstep = 2 * hstep;
    const unsigned ldsw = (unsigned)wid * 1024u;
    const int aoff = lds_byte(wr * 64 + fr, fq * 8), boff = lds_byte(wc * 32 + fr, fq * 8);
#define PG8_SA(b, h) (((b) * 2 + (h)) * HTB)
#define PG8_SB(b, h) ((4 + (b) * 2 + (h)) * HTB)
#define PG8_STAGE(bufoff, gbase, voff) do { _Pragma("unroll") for (int _i = 0; _i < 2; ++_i) \
        __builtin_amdgcn_global_load_lds((const unsigned*)((const char*)(gbase) + (voff)[_i]), (PG8_LAS unsigned*)(lds + (bufoff) + ldsw + _i * 8192), 16, 0, 0); } while (0)
#define PG8_LDA(dst, b, h) do { _Pragma("unroll") for (int m = 0; m < 4; ++m) _Pragma("unroll") for (int k = 0; k < 2; ++k) dst[m][k] = *(const PG8_LAS bf16x8*)(lds + PG8_SA(b, h) + aoff + m * 2048 + k * 1024); } while (0)
#define PG8_LDB(dst, b, h) do { _Pragma("unroll") for (int n = 0; n < 2; ++n) _Pragma("unroll") for (int k = 0; k < 2; ++k) dst[n][k] = *(const PG8_LAS bf16x8*)(lds + PG8_SB(b, h) + boff + n * 2048 + k * 1024); } while (0)
#define PG8_MMA(ai, bj, At, Bt) do { __builtin_amdgcn_s_setprio(1); _Pragma("unroll") for (int m = 0; m < 4; ++m) _Pragma("unroll") for (int n = 0; n < 2; ++n) _Pragma("unroll") for (int k = 0; k < 2; ++k) \
        acc[ai][bj][m][n] = __builtin_amdgcn_mfma_f32_16x16x32_bf16(Bt[n][k], At[m][k], acc[ai][bj][m][n], 0, 0, 0); __builtin_amdgcn_s_setprio(0); } while (0)
#define PG8_WAIT_V(n) asm volatile("s_waitcnt vmcnt(" #n ")" ::: "memory")
#define PG8_WAIT_L(n) asm volatile("s_waitcnt lgkmcnt(" #n ")" ::: "memory")
#define PG8_BAR __builtin_amdgcn_s_barrier()
#define PG8_SCHED __builtin_amdgcn_sched_barrier(0)
    Unit cur, nxt; int ui = 0;
    if (!S.next(0, cur)) return;
    f32x4 acc[2][2][4][2];
#pragma unroll
    for (int a = 0; a < 2; ++a)
#pragma unroll
        for (int b = 0; b < 2; ++b)
#pragma unroll
            for (int m = 0; m < 4; ++m)
#pragma unroll
                for (int n = 0; n < 2; ++n) acc[a][b][m][n] = (f32x4){0.f, 0.f, 0.f, 0.f};
    bf16x8 At[4][2], B0[2][2], B1[2][2];
    const char* cA = (const char*)g.A + (size_t)cur.pm * tstep; const char* cB = (const char*)g.Bt + (size_t)cur.pn * tstep;
    S.a_ready(cur);
    if constexpr (SP2) {
        PG8_STAGE(PG8_SB(0, 0), cB, voffB); PG8_STAGE(PG8_SB(0, 1), cB + hstep, voffB); PG8_STAGE(PG8_SA(0, 0), cA, voffA); PG8_STAGE(PG8_SA(0, 1), cA + hstep, voffA);
        if (wr == 1) PG8_BAR;
        PG8_WAIT_V(2); PG8_BAR;
        PG8_STAGE(PG8_SB(1, 0), cB + kstep, voffB); PG8_STAGE(PG8_SA(1, 0), cA + kstep, voffA); PG8_STAGE(PG8_SB(1, 1), cB + hstep + kstep, voffB);
        PG8_WAIT_V(6); PG8_BAR;
    } else {
        PG8_STAGE(PG8_SB(0, 0), cB, voffB); PG8_STAGE(PG8_SA(0, 0), cA, voffA); PG8_STAGE(PG8_SB(0, 1), cB + hstep, voffB); PG8_STAGE(PG8_SA(0, 1), cA + hstep, voffA);
        if (wr == 1) PG8_BAR;
        PG8_WAIT_V(4); PG8_BAR;
        PG8_STAGE(PG8_SB(1, 0), cB + kstep, voffB); PG8_STAGE(PG8_SA(1, 0), cA + kstep, voffA); PG8_STAGE(PG8_SB(1, 1), cB + hstep + kstep, voffB);
        PG8_WAIT_V(6); PG8_BAR;
    }
    for (;;) {
        const bool has_next = S.next(ui + 1, nxt);
        const char* nA = has_next ? (const char*)g.A + (size_t)nxt.pm * tstep : cA; const char* nB = has_next ? (const char*)g.Bt + (size_t)nxt.pn * tstep : cB;
        for (int t = 0; t < nt; t += 2) {
            const bool last = (t == nt - 2);
            const char* a1 = cA + (size_t)(t + 1) * kstep;
            const char* a2 = last ? nA : cA + (size_t)(t + 2) * kstep; const char* b2 = last ? nB : cB + (size_t)(t + 2) * kstep;
            const char* a3 = a2 + kstep; const char* b3 = b2 + kstep;
            if (last && has_next) S.a_ready(nxt);
            if constexpr (SP2) {
            PG8_LDB(B0, 0, 0); PG8_LDB(B1, 0, 1); PG8_SCHED; PG8_LDA(At, 0, 0); PG8_STAGE(PG8_SA(1, 1), a1 + hstep, voffA);
            PG8_WAIT_V(8); PG8_WAIT_L(0); PG8_BAR; PG8_MMA(0, 0, At, B0); PG8_MMA(0, 1, At, B1); PG8_BAR; PG8_SCHED;
            PG8_LDA(At, 0, 1); PG8_STAGE(PG8_SB(0, 0), b2, voffB); PG8_STAGE(PG8_SB(0, 1), b2 + hstep, voffB); PG8_STAGE(PG8_SA(0, 0), a2, voffA);
            PG8_WAIT_V(8); PG8_WAIT_L(0); PG8_BAR; PG8_MMA(1, 0, At, B0); PG8_MMA(1, 1, At, B1); PG8_BAR; PG8_SCHED;
            PG8_LDB(B0, 1, 0); PG8_LDB(B1, 1, 1); PG8_SCHED; PG8_LDA(At, 1, 0); PG8_STAGE(PG8_SA(0, 1), a2 + hstep, voffA);
            PG8_WAIT_V(8); PG8_WAIT_L(0); PG8_BAR; PG8_MMA(0, 0, At, B0); PG8_MMA(0, 1, At, B1); PG8_BAR; PG8_SCHED;
            PG8_LDA(At, 1, 1); PG8_STAGE(PG8_SB(1, 0), b3, voffB); PG8_STAGE(PG8_SB(1, 1), b3 + hstep, voffB); PG8_STAGE(PG8_SA(1, 0), a3, voffA);
            PG8_WAIT_V(8); PG8_WAIT_L(0); PG8_BAR; PG8_MMA(1, 0, At, B0); PG8_MMA(1, 1, At, B1); PG8_BAR; PG8_SCHED;
            } else {
            PG8_LDB(B0, 0, 0); PG8_SCHED; PG8_LDA(At, 0, 0); PG8_STAGE(PG8_SA(1, 1), a1 + hstep, voffA);
            PG8_WAIT_L(8); PG8_BAR; PG8_WAIT_L(0); PG8_MMA(0, 0, At, B0); PG8_BAR; PG8_SCHED;
            PG8_LDB(B1, 0, 1); PG8_STAGE(PG8_SB(0, 0), b2, voffB);
            PG8_BAR; PG8_WAIT_L(0); PG8_MMA(0, 1, At, B1); PG8_BAR;
            PG8_LDA(At, 0, 1); PG8_STAGE(PG8_SA(0, 0), a2, voffA);
            PG8_BAR; PG8_WAIT_L(0); PG8_MMA(1, 0, At, B0); PG8_BAR; PG8_SCHED;
            PG8_STAGE(PG8_SB(0, 1), b2 + hstep, voffB);
            PG8_WAIT_V(6); PG8_BAR; PG8_MMA(1, 1, At, B1); PG8_BAR;
            PG8_LDB(B0, 1, 0); PG8_SCHED; PG8_LDA(At, 1, 0); PG8_STAGE(PG8_SA(0, 1), a2 + hstep, voffA);
            PG8_WAIT_L(8); PG8_BAR; PG8_WAIT_L(0); PG8_MMA(0, 0, At, B0); PG8_BAR; PG8_SCHED;
            PG8_LDB(B1, 1, 1); PG8_STAGE(PG8_SB(1, 0), b3, voffB);
            PG8_BAR; PG8_WAIT_L(0); PG8_MMA(0, 1, At, B1); PG8_BAR;
            PG8_LDA(At, 1, 1); PG8_STAGE(PG8_SA(1, 0), a3, voffA);
            PG8_BAR; PG8_WAIT_L(0); PG8_MMA(1, 0, At, B0); PG8_BAR; PG8_SCHED;
            PG8_STAGE(PG8_SB(1, 1), b3 + hstep, voffB);
            PG8_WAIT_V(6); PG8_BAR; PG8_MMA(1, 1, At, B1); PG8_BAR;
            }
        }
        if constexpr (ALIGN_EPI) { if (wr == 0) PG8_BAR; }
        if constexpr (!Epi::AFTER_DRAIN) { E(acc, cur, wr, wc, fr, fq); S.done(cur); }
        if (!has_next) break;
#pragma unroll
        for (int a = 0; a < 2; ++a)
#pragma unroll
            for (int b = 0; b < 2; ++b)
#pragma unroll
                for (int m = 0; m < 4; ++m)
#pragma unroll
                    for (int n = 0; n < 2; ++n) acc[a][b][m][n] = (f32x4){0.f, 0.f, 0.f, 0.f};
        cur = nxt; cA = nA; cB = nB; ++ui;
        if constexpr (ALIGN_EPI) { if (wr == 1) PG8_BAR; }
    }
    PG8_WAIT_V(0);
    if constexpr (!ALIGN_EPI) { if (wr == 0) PG8_BAR; }
    PG8_BAR;
    if constexpr (Epi::AFTER_DRAIN) { E.fused(acc, cur, wr, wc, fr, fq, lds, wid, lane); S.done(cur); }
#undef PG8_SA
#undef PG8_SB
#undef PG8_STAGE
#undef PG8_LDA
#undef PG8_LDB
#undef PG8_MMA
#undef PG8_WAIT_V
#undef PG8_WAIT_L
#undef PG8_BAR
#undef PG8_SCHED
}
}

#define LAS __attribute__((address_space(3)))
using pg8::bf16_t; using pg8::bf16x8; using pg8::f32x4; using pg8::f32x2; using pg8::u32x4; using pg8::u32x2;
constexpr int NTHR = 512;
constexpr int D = 1024, FF = 2816, SGD = 3072, SLAB = 32768, HSL = 16384;
constexpr int LDS_BYTES = 155648;
constexpr int TS = 272;
constexpr size_t MiB = 1u << 20;
constexpr size_t WS_LB = 0;
constexpr size_t WS_DEC = 1 * MiB;
constexpr size_t WS_SSQ = 4 * MiB;
constexpr size_t WS_STAT = 8 * MiB;
constexpr size_t WS_WB = 24 * MiB;
constexpr size_t WS_XB = 120 * MiB;
constexpr size_t WS_BIG = 184 * MiB;
constexpr size_t WS_END = 504 * MiB;
constexpr size_t WB_FFN = 0, WB_FFN_STRIDE = 8650752, WB_DN_OFF = 5767168;
constexpr size_t WB_SGU_IN = 34603008, WB_SGU_OUT = 40894464, WB_HG_IN = 44040192, WB_HG_OUT = 49283072;

struct Args { const float* in[17]; float* out; unsigned char* ws; };

#define LDS_WAIT() asm volatile("s_waitcnt lgkmcnt(0)" ::: "memory")
__device__ __forceinline__ unsigned f2bf(float f) { unsigned u = __builtin_bit_cast(unsigned, f); return (u + 0x7fffu + ((u >> 16) & 1u)) >> 16; }
#ifdef HG_CLAMP_G
__device__ __forceinline__ float h2f(unsigned short h) { const float v = (float)__builtin_bit_cast(_Float16, h); return (v >= -1.2f && v <= 0.f) ? v : -0.3f; }
#else
__device__ __forceinline__ float h2f(unsigned short h) { return (float)__builtin_bit_cast(_Float16, h); }
#endif
__device__ __forceinline__ float wave_sum(float v) {
#pragma unroll
    for (int o = 1; o < 64; o <<= 1) v += __shfl_xor(v, o);
    return v;
}

__device__ __forceinline__ void conv_item(const float* W, int ldw, int sc0, int K, const float* scale, bf16_t* WT, int n0, int k0, LAS float* scr, int lane) {
#pragma unroll 8
    for (int i = 0; i < 32; ++i) { const int kk = 2 * i + (lane >> 5); float v = W[(size_t)(k0 + kk) * ldw + sc0 + (lane & 31)]; if (scale) v *= scale[k0 + kk]; scr[kk * 33 + (lane & 31)] = v; }
    LDS_WAIT(); asm volatile("" ::: "memory");
    const int c = lane & 7;
#pragma unroll
    for (int j = 0; j < 4; ++j) { const int n = (lane >> 3) + 8 * j; const LAS float* s = scr + (8 * c) * 33 + n;
        u32x4 o; o.x = pg8::cvt_pk_bf16(s[0 * 33], s[1 * 33]); o.y = pg8::cvt_pk_bf16(s[2 * 33], s[3 * 33]); o.z = pg8::cvt_pk_bf16(s[4 * 33], s[5 * 33]); o.w = pg8::cvt_pk_bf16(s[6 * 33], s[7 * 33]);
        *(u32x4*)(WT + (size_t)(n0 + n) * K + k0 + 8 * c) = o; }
    LDS_WAIT(); asm volatile("" ::: "memory");
}
__device__ __forceinline__ void conv_matrix(int mode, const float* src0, const float* src1, int ldw, int K, int Ndst, const float* scale, bf16_t* dst, LAS float* scr, int gw, int ngw, int lane) {
    const int nblk = Ndst / 32, nitems = (K / 64) * nblk;
    for (int it = gw; it < nitems; it += ngw) {
        const int kb = it / nblk, nb = it % nblk, n0 = 32 * nb;
        const float* src = src0; int sc0 = n0;
        if (mode == 1) { const int tile = n0 >> 8, half = (n0 >> 7) & 1, i0 = n0 & 127; src = half ? src1 : src0; sc0 = 128 * tile + i0; }
        conv_item(src, ldw, sc0, K, scale, dst, n0, 64 * kb, scr, lane);
    }
}

__device__ __forceinline__ void prep_rows(const float* x, bf16_t* xb, float* ssq, int nrows, int gw, int ngw, int lane) {
    asm volatile("" : "+v"(lane)); asm volatile("" : "+s"(gw));
    for (int m = gw; m < nrows; m += ngw) {
        const f32x4* xr = (const f32x4*)(x + (size_t)m * D) + lane; u32x2* o = (u32x2*)(xb + (size_t)m * D) + lane;
#pragma unroll
        for (int j = 0; j < 4; ++j) { const f32x4 v = xr[64 * j]; u32x2 w; w.x = pg8::cvt_pk_bf16(v[0], v[1]); w.y = pg8::cvt_pk_bf16(v[2], v[3]); o[64 * j] = w;
            const float s = wave_sum((v[0] * v[0] + v[1] * v[1]) + (v[2] * v[2] + v[3] * v[3]));
            if (lane < 4) ssq[(size_t)m * 16 + 4 * j + lane] = (lane == 0) ? s : 0.f; }
    }
}
__device__ __forceinline__ void final_rows(float* x, const float* ssq, const float* fw, int nrows, int gw, int ngw, int lane) {
    asm volatile("" : "+v"(lane)); asm volatile("" : "+s"(gw));
    for (int m = gw; m < nrows; m += ngw) {
        const float rs = pg8::row_rstd(ssq, m);
        f32x4* xr = (f32x4*)(x + (size_t)m * D) + lane; const f32x4* wr = (const f32x4*)fw + lane;
#pragma unroll
        for (int j = 0; j < 4; ++j) { const f32x4 v = xr[64 * j]; xr[64 * j] = v * rs * wr[64 * j]; }
    }
}

__device__ __forceinline__ void load_tile_T(LAS unsigned char* T, const bf16_t* src, size_t pitch, int tid) {
#pragma unroll
    for (int i = 0; i < 4; ++i) { const int idx = tid + NTHR * i, s = idx & 127, cq = idx >> 7;
        const u32x4 v = *(const u32x4*)(src + (size_t)s * pitch + cq * 8);
        LAS unsigned short* p = (LAS unsigned short*)(T + (cq * 8) * TS + s * 2);
        p[0 * (TS / 2)] = (unsigned short)(v.x & 0xffff); p[1 * (TS / 2)] = (unsigned short)(v.x >> 16);
        p[2 * (TS / 2)] = (unsigned short)(v.y & 0xffff); p[3 * (TS / 2)] = (unsigned short)(v.y >> 16);
        p[4 * (TS / 2)] = (unsigned short)(v.z & 0xffff); p[5 * (TS / 2)] = (unsigned short)(v.z >> 16);
        p[6 * (TS / 2)] = (unsigned short)(v.w & 0xffff); p[7 * (TS / 2)] = (unsigned short)(v.w >> 16); }
}
#define FRAG(base, row, kk) (*(const LAS bf16x8*)((base) + (row) * TS + ((kk) * 32 + 8 * fq) * 2))

__device__ __forceinline__ void sgu_mix(LAS unsigned char* lds, bf16_t* VS, const f32x2* stats, const float* w_s, const float* b_s, const float* lng, const float* lnb, int G, int bid, int tid) {
    asm volatile("" : "+v"(tid));
    const int lane = tid & 63, wid = tid >> 6, wr = wid >> 2, wc = wid & 3, fr = lane & 15, fq = lane >> 4;
    LAS unsigned char* WT = lds; LAS unsigned char* VT = lds + 34816;
    LAS float* MU = (LAS float*)(lds + 69632); LAS float* RS = MU + 128; LAS float* MT = MU + 256; LAS float* RWS = MU + 384;
#pragma unroll 1
    for (int chunk = bid; chunk < SLAB / 128; chunk += G) {
        const int r0 = chunk * 128;
        if (tid < 128) { const f32x2* sp = stats + (size_t)(r0 + tid) * 48; float s1 = 0.f, s2 = 0.f;
#pragma unroll 8
            for (int j = 0; j < 48; ++j) { const f32x2 v = sp[j]; s1 += v.x; s2 += v.y; }
            const float mu = s1 * (1.0f / 3072.0f); const float var = s2 * (1.0f / 3072.0f) - mu * mu; MU[tid] = mu; RS[tid] = rsqrtf(fmaxf(var, 0.f) + 1e-6f); }
        __syncthreads();
#pragma unroll 1
        for (int g = 0; g < 8; ++g) {
            { const int t = tid >> 2, sq = tid & 3; const float* wrow = w_s + ((size_t)g * 128 + t) * 128 + sq * 32; float macc = 0.f, rw = 0.f;
#pragma unroll
                for (int i = 0; i < 4; ++i) { const f32x4 a = *(const f32x4*)(wrow + 8 * i), b = *(const f32x4*)(wrow + 8 * i + 4); const int s0 = sq * 32 + 8 * i;
                    rw += ((a[0] + a[1]) + (a[2] + a[3])) + ((b[0] + b[1]) + (b[2] + b[3]));
                    u32x4 w; w.x = pg8::cvt_pk_bf16(a[0] * RS[s0 + 0], a[1] * RS[s0 + 1]); w.y = pg8::cvt_pk_bf16(a[2] * RS[s0 + 2], a[3] * RS[s0 + 3]);
                    w.z = pg8::cvt_pk_bf16(b[0] * RS[s0 + 4], b[1] * RS[s0 + 5]); w.w = pg8::cvt_pk_bf16(b[2] * RS[s0 + 6], b[3] * RS[s0 + 7]);
                    macc += pg8::bflo(w.x) * MU[s0 + 0] + pg8::bfhi(w.x) * MU[s0 + 1] + pg8::bflo(w.y) * MU[s0 + 2] + pg8::bfhi(w.y) * MU[s0 + 3]
                          + pg8::bflo(w.z) * MU[s0 + 4] + pg8::bfhi(w.z) * MU[s0 + 5] + pg8::bflo(w.w) * MU[s0 + 6] + pg8::bfhi(w.w) * MU[s0 + 7];
                    *(LAS u32x4*)(WT + t * TS + s0 * 2) = w; }
                macc += __shfl_xor(macc, 1); macc += __shfl_xor(macc, 2); rw += __shfl_xor(rw, 1); rw += __shfl_xor(rw, 2);
                if (sq == 0) { MT[t] = macc; RWS[t] = rw; } }
            __syncthreads();
#pragma unroll 1
            for (int cbi = 0; cbi < 3; ++cbi) {
                const int c0 = g * 384 + cbi * 128;
                load_tile_T(VT, VS + (size_t)r0 * SGD + c0, SGD, tid);
                __syncthreads();
                f32x4 acc[4][2];
#pragma unroll
                for (int m = 0; m < 4; ++m) { acc[m][0] = (f32x4){0.f, 0.f, 0.f, 0.f}; acc[m][1] = (f32x4){0.f, 0.f, 0.f, 0.f}; }
#pragma unroll
                for (int kk = 0; kk < 4; ++kk) { bf16x8 Af[4], Bf[2];
#pragma unroll
                    for (int m = 0; m < 4; ++m) Af[m] = FRAG(WT, 64 * wr + 16 * m + fr, kk);
#pragma unroll
                    for (int n = 0; n < 2; ++n) Bf[n] = FRAG(VT, 32 * wc + 16 * n + fr, kk);
#pragma unroll
                    for (int m = 0; m < 4; ++m)
#pragma unroll
                        for (int n = 0; n < 2; ++n) acc[m][n] = __builtin_amdgcn_mfma_f32_16x16x32_bf16(Bf[n], Af[m], acc[m][n], 0, 0, 0); }
#pragma unroll
                for (int m = 0; m < 4; ++m) { const int t = 64 * wr + 16 * m + fr; const float mt = MT[t], rwt = RWS[t], bst = b_s[g * 128 + t];
#pragma unroll
                    for (int n = 0; n < 2; ++n) { const int c4 = c0 + 32 * wc + 16 * n + 4 * fq; const f32x4 lg = *(const f32x4*)(lng + c4), lb = *(const f32x4*)(lnb + c4);
                        const f32x4 v = lg * (acc[m][n] - mt) + lb * rwt + bst; u32x2 w; w.x = pg8::cvt_pk_bf16(v[0], v[1]); w.y = pg8::cvt_pk_bf16(v[2], v[3]);
                        *(u32x2*)(VS + (size_t)(r0 + t) * SGD + c4) = w; } }
                __syncthreads();
            }
        }
    }
}

__device__ __forceinline__ void hgrn_pass_a(LAS unsigned char* lds, const bf16_t* GF, const bf16_t* GB, const bf16_t* IV, bf16_t* ST, float* DEC, int G, int bid, int tid) {
    asm volatile("" : "+v"(tid));
    const int lane = tid & 63, wid = tid >> 6, wr = wid >> 2, wc = wid & 3, fr = lane & 15, fq = lane >> 4;
    LAS unsigned char* VT = lds; LAS unsigned char* KT = lds + 34816; LAS float* PART = (LAS float*)(lds + 69632);
    const int k = tid & 127, qr = tid >> 7;
#pragma unroll 1
    for (int item = bid; item < 1024; item += G) {
        const int seg = item >> 3, h = item & 7, r0 = seg * 128, cb = h * 128;
        load_tile_T(VT, IV + (size_t)r0 * D + cb, D, tid);
#pragma unroll 1
        for (int dir = 0; dir < 2; ++dir) {
            const bf16_t* Gp = (dir ? GB : GF) + (size_t)(r0 + 32 * qr) * D + cb + k;
            float sum = 0.f;
#pragma unroll 8
            for (int i = 0; i < 32; ++i) sum += h2f(Gp[(size_t)i * D]);
            PART[qr * 128 + k] = sum;
            __syncthreads();
            const float p0 = PART[k], p1 = PART[128 + k], p2 = PART[256 + k], p3 = PART[384 + k];
            LAS unsigned short* kt = (LAS unsigned short*)(KT + k * TS) + 32 * qr;
            if (dir == 0) {
                float run = (qr == 0) ? (p1 + p2 + p3) : (qr == 1) ? (p2 + p3) : (qr == 2) ? p3 : 0.f;
#pragma unroll 4
                for (int i = 31; i >= 0; --i) { const float gi = h2f(Gp[(size_t)i * D]); kt[i] = (unsigned short)f2bf((1.0f - __expf(gi)) * __expf(run)); run += gi; }
            } else {
                float run = (qr == 0) ? 0.f : (qr == 1) ? p0 : (qr == 2) ? (p0 + p1) : (p0 + p1 + p2);
#pragma unroll 4
                for (int i = 0; i < 32; ++i) { const float gi = h2f(Gp[(size_t)i * D]); kt[i] = (unsigned short)f2bf((1.0f - __expf(gi)) * __expf(run)); run += gi; }
            }
            const size_t idx = ((size_t)(seg * 8 + h) * 2 + dir);
            if (qr == 0) DEC[idx * 128 + k] = __expf((p0 + p1) + (p2 + p3));
            __syncthreads();
            f32x4 acc[4][2];
#pragma unroll
            for (int m = 0; m < 4; ++m) { acc[m][0] = (f32x4){0.f, 0.f, 0.f, 0.f}; acc[m][1] = (f32x4){0.f, 0.f, 0.f, 0.f}; }
#pragma unroll
            for (int kk = 0; kk < 4; ++kk) { bf16x8 Af[4], Bf[2];
#pragma unroll
                for (int m = 0; m < 4; ++m) Af[m] = FRAG(KT, 64 * wr + 16 * m + fr, kk);
#pragma unroll
                for (int n = 0; n < 2; ++n) Bf[n] = FRAG(VT, 32 * wc + 16 * n + fr, kk);
#pragma unroll
                for (int m = 0; m < 4; ++m)
#pragma unroll
                    for (int n = 0; n < 2; ++n) acc[m][n] = __builtin_amdgcn_mfma_f32_16x16x32_bf16(Af[m], Bf[n], acc[m][n], 0, 0, 0); }
            bf16_t* so = ST + idx * 16384;
#pragma unroll
            for (int m = 0; m < 4; ++m)
#pragma unroll
                for (int n = 0; n < 2; ++n) { const int v = 32 * wc + 16 * n + fr, k4 = 64 * wr + 16 * m + 4 * fq; u32x2 w; w.x = pg8::cvt_pk_bf16(acc[m][n][0], acc[m][n][1]); w.y = pg8::cvt_pk_bf16(acc[m][n][2], acc[m][n][3]);
                    *(u32x2*)(so + v * 128 + k4) = w; }
            __syncthreads();
        }
    }
}
__device__ __forceinline__ void hgrn_pass_b(bf16_t* ST, const float* DEC, int nseq, int nseg, int G, int bid, int tid) {
    asm volatile("" : "+v"(tid));
    const int total = nseq * 16 * 4096;
    for (int w = bid * NTHR + tid; w < total; w += G * NTHR) {
        const int e4 = w & 4095, sh = w >> 12, dir = sh & 1, h = (sh >> 1) & 7, seq = sh >> 4, k0 = (e4 * 4) & 127;
        f32x4 S = (f32x4){0.f, 0.f, 0.f, 0.f};
#pragma unroll 4
        for (int j = 0; j < nseg; ++j) { const int segi = dir ? (nseg - 1 - j) : j; const size_t idx = ((size_t)((seq * nseg + segi) * 8 + h) * 2 + dir);
            u32x2* p = (u32x2*)(ST + idx * 16384 + e4 * 4); const u32x2 uv = *p; const f32x4 d = *(const f32x4*)(DEC + idx * 128 + k0);
            u32x2 o; o.x = pg8::cvt_pk_bf16(S[0], S[1]); o.y = pg8::cvt_pk_bf16(S[2], S[3]); *p = o;
            S = d * S + (f32x4){pg8::bflo(uv.x), pg8::bfhi(uv.x), pg8::bflo(uv.y), pg8::bfhi(uv.y)}; }
    }
}
__device__ __forceinline__ void hgrn_pass_c(LAS unsigned char* lds, const bf16_t* QSg, const bf16_t* GF, const bf16_t* GB, const bf16_t* IV, const bf16_t* GS, const bf16_t* ST, const float* normw, bf16_t* OB, int G, int bid, int tid) {
    asm volatile("" : "+v"(tid));
    const int lane = tid & 63, wid = tid >> 6, wr = wid >> 2, wc = wid & 3, fr = lane & 15, fq = lane >> 4;
    LAS unsigned char* QS = lds; LAS unsigned char* PP = lds + 34816; LAS unsigned char* Q1 = lds + 69632; LAS unsigned char* KDA = lds + 87040;
    LAS unsigned char* KEA = lds + 104448; LAS unsigned char* KDB = lds + 121856; LAS unsigned char* STL = Q1; LAS unsigned char* VT = KEA;
    LAS float* PART = (LAS float*)(lds + 139264); LAS float* RED = (LAS float*)(lds + 141312);
    const int k = tid & 127, qr = tid >> 7;
#pragma unroll 1
    for (int item = bid; item < 1024; item += G) {
        const int seg = item >> 3, h = item & 7, r0 = seg * 128, cb = h * 128;
        f32x4 acc[4][2];
#pragma unroll
        for (int m = 0; m < 4; ++m) { acc[m][0] = (f32x4){0.f, 0.f, 0.f, 0.f}; acc[m][1] = (f32x4){0.f, 0.f, 0.f, 0.f}; }
#pragma unroll 1
        for (int dir = 0; dir < 2; ++dir) {
            const bf16_t* Gp = (dir ? GB : GF) + (size_t)r0 * D + cb + k; const bf16_t* Qp = QSg + (size_t)r0 * D + cb + k;
            {
                float sum = 0.f;
#pragma unroll 8
                for (int i = 0; i < 32; ++i) { const int p = 32 * qr + i, t = dir ? (127 - p) : p; sum += h2f(Gp[(size_t)t * D]); }
                PART[qr * 128 + k] = sum;
                __syncthreads();
                float run = (qr & 1) ? PART[(qr - 1) * 128 + k] : 0.f;
                const float r1 = PART[k] + PART[128 + k];
                const bool inB = qr >= 2;
#pragma unroll 4
                for (int i = 0; i < 32; ++i) { const int p = 32 * qr + i, t = dir ? (127 - p) : p, tl = t & 63; const float gi = h2f(Gp[(size_t)t * D]); run += gi;
                    const float q = pg8::bf2f(Qp[(size_t)t * D]); const float kkv = 1.0f - __expf(gi);
                    if (!inB) {
                        *((LAS unsigned short*)(QS + t * TS) + k) = (unsigned short)f2bf(q * __expf(run));
                        *((LAS unsigned short*)(KDA + tl * TS) + k) = (unsigned short)f2bf(kkv * __expf(-run));
                        *((LAS unsigned short*)(KEA + tl * TS) + k) = (unsigned short)f2bf(kkv * __expf(r1 - run));
                    } else {
                        *((LAS unsigned short*)(Q1 + tl * TS) + k) = (unsigned short)f2bf(q * __expf(run));
                        *((LAS unsigned short*)(QS + t * TS) + k) = (unsigned short)f2bf(q * __expf(r1 + run));
                        *((LAS unsigned short*)(KDB + tl * TS) + k) = (unsigned short)f2bf(kkv * __expf(-run));
                    } }
            }
            __syncthreads();
            {
                const int ct = wid >> 2; const bool tA = (ct == dir);
                const LAS unsigned char* qb = tA ? (QS + (16 * wid) * TS) : (Q1 + ((16 * wid) & 63) * TS);
                bf16x8 Qf[4];
#pragma unroll
                for (int kk = 0; kk < 4; ++kk) Qf[kk] = FRAG(qb, fr, kk);
                const int t = 16 * wid + fr;
#pragma unroll
                for (int j = 0; j < 8; ++j) { const int cs = j >> 2; const bool sA = (cs == dir);
                    f32x4 pacc = (f32x4){0.f, 0.f, 0.f, 0.f};
                    if (!(tA && !sA)) {
                        const LAS unsigned char* kb = (tA ? KDA : (sA ? KEA : KDB)) + ((16 * j) & 63) * TS;
#pragma unroll
                        for (int kk = 0; kk < 4; ++kk) pacc = __builtin_amdgcn_mfma_f32_16x16x32_bf16(FRAG(kb, fr, kk), Qf[kk], pacc, 0, 0, 0);
                        if (tA == sA) {
#pragma unroll
                            for (int r = 0; r < 4; ++r) { const int s = 16 * j + 4 * fq + r; const bool keep = dir ? (s >= t) : (s <= t); if (!keep) pacc[r] = 0.f; }
                        }
                    }
#ifdef HG_SAN_P
                    for (int r = 0; r < 4; ++r) if (!(fabsf(pacc[r]) < 1e6f)) pacc[r] = 0.f;
#endif
                    u32x2 w; w.x = pg8::cvt_pk_bf16(pacc[0], pacc[1]); w.y = pg8::cvt_pk_bf16(pacc[2], pacc[3]);
                    *(LAS u32x2*)(PP + t * TS + (16 * j + 4 * fq) * 2) = w; }
            }
            __syncthreads();
            {
                const u32x4* sg = (const u32x4*)(ST + ((size_t)(seg * 8 + h) * 2 + dir) * 16384);
#pragma unroll
                for (int i = 0; i < 4; ++i) { const int c = tid + NTHR * i; u32x4 sv = sg[c];
#ifdef HG_SAN_ST
                    { unsigned* pw = (unsigned*)&sv; for (int e = 0; e < 4; ++e) { unsigned w = pw[e]; if ((w & 0x7f80u) == 0x7f80u) w &= 0xffff0000u; if ((w & 0x7f800000u) == 0x7f800000u) w &= 0x0000ffffu; pw[e] = w; } }
#endif
                    *(LAS u32x4*)(STL + (c >> 4) * TS + (c & 15) * 16) = sv; }
                load_tile_T(VT, IV + (size_t)r0 * D + cb, D, tid);
            }
            __syncthreads();
#pragma unroll
            for (int kk = 0; kk < 4; ++kk) { bf16x8 Af[4], Bf[2];
#pragma unroll
                for (int m = 0; m < 4; ++m) Af[m] = FRAG(PP, 64 * wr + 16 * m + fr, kk);
#pragma unroll
                for (int n = 0; n < 2; ++n) Bf[n] = FRAG(VT, 32 * wc + 16 * n + fr, kk);
#pragma unroll
                for (int m = 0; m < 4; ++m)
#pragma unroll
                    for (int n = 0; n < 2; ++n) acc[m][n] = __builtin_amdgcn_mfma_f32_16x16x32_bf16(Bf[n], Af[m], acc[m][n], 0, 0, 0);
#pragma unroll
                for (int m = 0; m < 4; ++m) Af[m] = FRAG(QS, 64 * wr + 16 * m + fr, kk);
#pragma unroll
                for (int n = 0; n < 2; ++n) Bf[n] = FRAG(STL, 32 * wc + 16 * n + fr, kk);
#pragma unroll
                for (int m = 0; m < 4; ++m)
#pragma unroll
                    for (int n = 0; n < 2; ++n) acc[m][n] = __builtin_amdgcn_mfma_f32_16x16x32_bf16(Bf[n], Af[m], acc[m][n], 0, 0, 0); }
            __syncthreads();
        }
#pragma unroll
        for (int m = 0; m < 4; ++m) { float ss = 0.f;
#pragma unroll
            for (int n = 0; n < 2; ++n) ss += (acc[m][n][0] * acc[m][n][0] + acc[m][n][1] * acc[m][n][1]) + (acc[m][n][2] * acc[m][n][2] + acc[m][n][3] * acc[m][n][3]);
            ss += __shfl_xor(ss, 16); ss += __shfl_xor(ss, 32);
            if (fq == 0) RED[(64 * wr + 16 * m + fr) * 4 + wc] = ss; }
        __syncthreads();
#pragma unroll
        for (int m = 0; m < 4; ++m) { const int t = 64 * wr + 16 * m + fr; const f32x4 rr = *(const LAS f32x4*)(RED + t * 4);
            const float rstd = rsqrtf(((rr[0] + rr[1]) + (rr[2] + rr[3])) * (1.0f / 128.0f) + 1e-6f);
#pragma unroll
            for (int n = 0; n < 2; ++n) { const int v4 = cb + 32 * wc + 16 * n + 4 * fq; const f32x4 nw = *(const f32x4*)(normw + v4);
                const u32x2 gsv = *(const u32x2*)(GS + (size_t)(r0 + t) * D + v4);
                const f32x4 gs = (f32x4){pg8::bflo(gsv.x), pg8::bfhi(gsv.x), pg8::bflo(gsv.y), pg8::bfhi(gsv.y)};
                f32x4 o = acc[m][n] * rstd * nw * gs; u32x2 w;
#ifdef HG_SANITIZE
                for (int j = 0; j < 4; ++j) o[j] = (fabsf(o[j]) < 1e30f) ? o[j] : 0.f;
#endif
 w.x = pg8::cvt_pk_bf16(o[0], o[1]); w.y = pg8::cvt_pk_bf16(o[2], o[3]);
                *(u32x2*)(OB + (size_t)(r0 + t) * D + v4) = w; } }
        __syncthreads();
    }
}

#define GSYNC() do { asm volatile("s_waitcnt vmcnt(0) lgkmcnt(0)" ::: "memory"); __syncthreads(); grid.sync(); __builtin_amdgcn_fence(__ATOMIC_ACQUIRE, "agent"); asm volatile("s_waitcnt vmcnt(0)" ::: "memory"); } while (0)
template <class Epi> __device__ __forceinline__ void run_gemm(LAS unsigned char* lds, const bf16_t* A, const bf16_t* Bt, int M, int N, int K, const Epi& E, int G, int bid) {
    pg8::Gemm g{A, Bt, M, N, K}; pg8::StaticOrder S; S.init(M, N, G, bid);
    pg8::gemm_phase<Epi, pg8::StaticOrder, true, true>(lds, g, S, E);
}

__global__ void __launch_bounds__(NTHR, 2) mega_fwd(Args a) {
    extern __shared__ __attribute__((aligned(16))) unsigned char lds_raw[];
    LAS unsigned char* lds = (LAS unsigned char*)lds_raw;
    cg::grid_group grid = cg::this_grid();
    const int tid = threadIdx.x, lane = tid & 63, wave = __builtin_amdgcn_readfirstlane(tid >> 6);
    const int G = gridDim.x, bid = blockIdx.x, gw = bid * 8 + wave, ngw = G * 8;
    unsigned char* ws = a.ws;
    float* LB = (float*)(ws + WS_LB); float* DEC = (float*)(ws + WS_DEC); float* SSQ = (float*)(ws + WS_SSQ); f32x2* STAT = (f32x2*)(ws + WS_STAT);
    bf16_t* WB = (bf16_t*)(ws + WS_WB); bf16_t* XB = (bf16_t*)(ws + WS_XB); bf16_t* BIG = (bf16_t*)(ws + WS_BIG);
    const float* norm_w = a.in[2];

    {
        LAS float* scr = (LAS float*)(lds + wave * 16384);
        for (int l = 0; l < 2; ++l)
            for (int j = 0; j < 2; ++j) { const size_t wo = (size_t)(l * 2 + j);
                conv_matrix(1, a.in[3] + wo * D * FF, a.in[4] + wo * D * FF, FF, D, 2 * FF, norm_w + (l * 3 + (j ? 2 : 0)) * D, WB + WB_FFN + wo * WB_FFN_STRIDE, scr, gw, ngw, lane);
                conv_matrix(0, a.in[5] + wo * FF * D, nullptr, D, FF, D, nullptr, WB + WB_FFN + wo * WB_FFN_STRIDE + WB_DN_OFF, scr, gw, ngw, lane); }
        conv_matrix(0, a.in[6], nullptr, 2 * SGD, D, 2 * SGD, norm_w + 1 * D, WB + WB_SGU_IN, scr, gw, ngw, lane);
        conv_matrix(0, a.in[11], nullptr, D, SGD, D, nullptr, WB + WB_SGU_OUT, scr, gw, ngw, lane);
        conv_matrix(0, a.in[12], nullptr, 5 * D, D, 5 * D, norm_w + 4 * D, WB + WB_HG_IN, scr, gw, ngw, lane);
        conv_matrix(0, a.in[15], nullptr, D, D, D, nullptr, WB + WB_HG_OUT, scr, gw, ngw, lane);
        for (int i = bid * NTHR + tid; i < 2048; i += G * NTHR) { const int d = i >> 10, kq = i & 1023; const float* raw = a.in[13] + d * 2048;
            LB[i] = 1.0f / (1.0f + __expf(raw[kq] - raw[1024 + kq])); }
    }
    GSYNC();

#pragma unroll 1
    for (int s = 0; s < 2; ++s) {
        const float* xin = a.in[s]; float* xo = a.out + (size_t)s * SLAB * D;
        prep_rows(xin, XB, SSQ, SLAB, gw, ngw, lane);
        GSYNC();
#pragma unroll 1
        for (int st = 0; st < 6; ++st) {
#ifndef NO_SGU
            if (st == 1) {
                { pg8::EpiSguV E{BIG, SSQ, STAT}; run_gemm(lds, XB, WB + WB_SGU_IN + (size_t)SGD * D, SLAB, SGD, D, E, G, bid); }
                GSYNC();
                sgu_mix(lds, BIG, STAT, a.in[9], a.in[10], a.in[7], a.in[8], G, bid, tid);
                GSYNC();
                { pg8::EpiSguU E{BIG, SSQ}; run_gemm(lds, XB, WB + WB_SGU_IN, SLAB, SGD, D, E, G, bid); }
                GSYNC();
                { pg8::EpiDown E{xo, xo, XB, SSQ, 1.0f}; run_gemm(lds, BIG, WB + WB_SGU_OUT, SLAB, D, SGD, E, G, bid); }
                GSYNC();
            } else
#endif
#ifndef NO_HGRN
            if (st == 4) {
                bf16_t* QSb = BIG; const size_t hst = (size_t)HSL * D; bf16_t* GFb = BIG + hst; bf16_t* GBb = BIG + 2 * hst; bf16_t* IVb = BIG + 3 * hst; bf16_t* GSb = BIG + 4 * hst; bf16_t* OBb = BIG + 5 * hst; bf16_t* STb = BIG + 6 * hst;
#pragma unroll 1
                for (int hf = 0; hf < 2; ++hf) {
                    const size_t ro = (size_t)hf * HSL;
                    { pg8::EpiHgrn E{BIG, hst, SSQ + ro * 16, LB}; run_gemm(lds, XB + ro * D, WB + WB_HG_IN, HSL, 5 * D, D, E, G, bid); }
                    GSYNC();
#ifndef HG_SKIP_A
                    hgrn_pass_a(lds, GFb, GBb, IVb, STb, DEC, G, bid, tid);
#endif
                    GSYNC();
#ifndef HG_SKIP_B
                    hgrn_pass_b(STb, DEC, s == 0 ? 8 : 2, s == 0 ? 16 : 64, G, bid, tid);
#endif
                    GSYNC();
#ifndef HG_SKIP_C
                    hgrn_pass_c(lds, QSb, GFb, GBb, IVb, GSb, STb, a.in[14], OBb, G, bid, tid);
#else
                    OBb = QSb;
#endif
                    GSYNC();
                    { pg8::EpiDown E{xo + ro * D, xo + ro * D, XB + ro * D, SSQ + ro * 16, 1.0f}; run_gemm(lds, OBb, WB + WB_HG_OUT, HSL, D, D, E, G, bid); }
                    GSYNC();
                }
            } else
#endif
            {
                const int fi = (st == 0) ? 0 : (st == 2) ? 1 : (st == 3) ? 2 : 3;
                const bf16_t* wgu = WB + WB_FFN + (size_t)fi * WB_FFN_STRIDE;
                { pg8::EpiSwiGLU E{BIG, FF, SSQ}; run_gemm(lds, XB, wgu, SLAB, 2 * FF, D, E, G, bid); }
                GSYNC();
                { pg8::EpiDown E{st == 0 ? xin : (const float*)xo, xo, XB, SSQ, 0.5f}; run_gemm(lds, BIG, wgu + WB_DN_OFF, SLAB, D, FF, E, G, bid); }
                GSYNC();
            }
        }
        final_rows(xo, SSQ, a.in[16], SLAB, gw, ngw, lane);
        GSYNC();
    }
}

extern "C" void kernel_launch(void* const* d_in, const int* in_sizes, int n_in, void* d_out, int out_size, void* d_ws, size_t ws_size, hipStream_t stream) {
    static int grid = 0;
    if (grid == 0) {
        if (n_in != 17 || out_size != 2 * SLAB * D || ws_size < WS_END) { fprintf(stderr, "kernel_launch: unexpected problem (n_in %d, out %d, ws %zu)\n", n_in, out_size, ws_size); grid = -1; return; }
        int dev = 0, cus = 0, per_cu = 0;
        hipGetDevice(&dev); hipDeviceGetAttribute(&cus, hipDeviceAttributeMultiprocessorCount, dev);
        hipFuncSetAttribute((const void*)mega_fwd, hipFuncAttributeMaxDynamicSharedMemorySize, LDS_BYTES);
        hipOccupancyMaxActiveBlocksPerMultiprocessor(&per_cu, (const void*)mega_fwd, NTHR, LDS_BYTES);
        if (per_cu < 1) { fprintf(stderr, "kernel_launch: occupancy query says %d blocks/CU\n", per_cu); per_cu = 1; }
        (void)hipGetLastError();
        grid = cus;
    }
    if (grid < 0) return;
    Args a{};
    for (int i = 0; i < 17; ++i) a.in[i] = (const float*)d_in[i];
    a.out = (float*)d_out; a.ws = (unsigned char*)d_ws;
    void* args[] = {&a};
    hipError_t e = hipLaunchCooperativeKernel((const void*)mega_fwd, dim3(grid), dim3(NTHR), args, LDS_BYTES, stream);
    if (e != hipSuccess) fprintf(stderr, "cooperative launch failed: %s (grid %d)\n", hipGetErrorString(e), grid);
}
```

```cpp
#include <hip/hip_runtime.h>
#include <hip/hip_cooperative_groups.h>
#include <cstdio>
#include <cstdint>
namespace cg = cooperative_groups;
namespace pg8 {
#define PG8_LAS __attribute__((address_space(3)))
typedef unsigned short bf16_t;
typedef short bf16x8 __attribute__((ext_vector_type(8)));
typedef float f32x4 __attribute__((ext_vector_type(4)));
typedef unsigned u32x4 __attribute__((ext_vector_type(4)));
constexpr int BM = 256, BK = 64, HALF = 128, HTB = HALF * BK * 2  , STAGE_BYTES = 8 * HTB, NXCD = 8, WGM = 8;

__host__ __device__ __forceinline__ int lds_byte(int r, int c) { const int st = (r >> 4) * 2 + (c >> 5), rr = r & 15, cc = c & 31, ob = rr * 64 + cc * 2; return st * 1024 + (ob ^ (((ob >> 9) & 1) << 5)); }
__host__ __device__ __forceinline__ void stage_rc(int b, int& R, int& C) { const int st = b / 1024, sb = b % 1024, swz = sb ^ (((sb >> 9) & 1) << 5); R = (st >> 1) * 16 + swz / 64; C = (st & 1) * 32 + (swz % 64) / 2; }
__host__ __device__ __forceinline__ int perm32(int rho) { const int n = rho >> 4, i = rho & 15; return 8 * (i >> 2) + 4 * n + (i & 3); }

struct Unit { int pm, pn; };
struct Gemm { const bf16_t* A; const bf16_t* Bt; int M, N, K; };

struct StaticOrder {
    int nM, nN, nwg, G, c;
    __host__ __device__ void init(int M, int N, int G_, int c_) { nM = M / BM; nN = N / BM; nwg = nM * nN; G = G_; c = c_; }
    __host__ __device__ bool next(int i, Unit& u) const {
        const long L = (long)i * G + c; if (L >= nwg) return false;
        int wgid = (int)L; { const int q = nwg / NXCD, r = nwg % NXCD, xcd = wgid % NXCD, off = wgid / NXCD; wgid = (xcd < r ? xcd * (q + 1) : r * (q + 1) + (xcd - r) * q) + off; }
        const int nig = WGM * nN, gid = wgid / nig, fm = gid * WGM, gsz = (nM - fm) < WGM ? (nM - fm) : WGM;
        u.pm = fm + ((wgid % nig) % gsz); u.pn = (wgid % nig) / gsz; return true;
    }
    __device__ __forceinline__ void a_ready(const Unit&) const {}
    __device__ __forceinline__ void done(const Unit&) const {}
};


typedef float f32x2 __attribute__((ext_vector_type(2)));
typedef __bf16 bf16x2_t __attribute__((ext_vector_type(2)));
__device__ __forceinline__ unsigned cvt_pk_bf16(float lo, float hi) { const f32x2 f = {lo, hi}; const bf16x2_t v = __builtin_convertvector(f, bf16x2_t); return __builtin_bit_cast(unsigned, v); }
typedef unsigned u32x2 __attribute__((ext_vector_type(2)));
__device__ __forceinline__ f32x2 gelu_pk(f32x2 v) {
    const f32x2 av = __builtin_elementwise_abs(v), d = av * 0.2316418882f + 1.0f;
    f32x2 t; t.x = __builtin_amdgcn_rcpf(d.x); t.y = __builtin_amdgcn_rcpf(d.y);
    f32x2 q = t * 0.5307027145f + (-0.7265760135f); q = q * t + 0.7107068705f; q = q * t + (-0.142248368f); q = q * t + 0.127414796f; q = q * t;
    const f32x2 s = (v * v) * (-0.72134752044f);
    f32x2 e; e.x = __builtin_amdgcn_exp2f(s.x); e.y = __builtin_amdgcn_exp2f(s.y);
    const f32x2 m = v * (q * e), r = v - m;
    f32x2 o; o.x = v.x < 0.f ? m.x : r.x; o.y = v.y < 0.f ? m.y : r.y; return o;
}
__device__ __forceinline__ f32x4 gelu4(f32x4 v) { const f32x2 a = gelu_pk((f32x2){v[0], v[1]}), b = gelu_pk((f32x2){v[2], v[3]}); return (f32x4){a.x, a.y, b.x, b.y}; }
__device__ __forceinline__ float silu1(float x) { return x * __builtin_amdgcn_rcpf(1.0f + __expf(-x)); }
__device__ __forceinline__ f32x4 silu4(f32x4 v) { return (f32x4){silu1(v[0]), silu1(v[1]), silu1(v[2]), silu1(v[3])}; }
__device__ __forceinline__ float bf2f(unsigned short b) { return __uint_as_float(((unsigned)b) << 16); }
__device__ __forceinline__ float bflo(unsigned w) { return __uint_as_float(w << 16); }
__device__ __forceinline__ float bfhi(unsigned w) { return __uint_as_float(w & 0xffff0000u); }
__device__ __forceinline__ float row_rstd(const float* ssq, int row) {
    const f32x4* p = (const f32x4*)(ssq + (size_t)row * 16);
    const f32x4 a = p[0], b = p[1], c = p[2], d = p[3];
    const float s = ((a[0] + a[1]) + (a[2] + a[3])) + ((b[0] + b[1]) + (b[2] + b[3])) + ((c[0] + c[1]) + (c[2] + c[3])) + ((d[0] + d[1]) + (d[2] + d[3]));
    return rsqrtf(s * (1.0f / 1024.0f) + 1e-6f);
}

struct EpiSwiGLU {
    static constexpr bool PERM = true, AFTER_DRAIN = false;
    bf16_t* H; int ldh; const float* ssq;
    __device__ __forceinline__ void operator()(const f32x4 (&acc)[2][2][4][2], const Unit& u, int wr, int wc, int fr, int fq) const {
        const int row0 = u.pm * BM + wr * 64 + fr, col0 = u.pn * HALF + wc * 32 + 8 * fq;
#pragma unroll
        for (int ai = 0; ai < 2; ++ai)
#pragma unroll
            for (int m = 0; m < 4; ++m) { const int row = row0 + ai * HALF + m * 16; const float rs = row_rstd(ssq, row);
                const f32x4 g0 = acc[ai][0][m][0] * rs, g1 = acc[ai][0][m][1] * rs, u0 = acc[ai][1][m][0] * rs, u1 = acc[ai][1][m][1] * rs;
                const f32x4 h0 = silu4(g0) * u0, h1 = silu4(g1) * u1;
                u32x4 w; w.x = cvt_pk_bf16(h0[0], h0[1]); w.y = cvt_pk_bf16(h0[2], h0[3]); w.z = cvt_pk_bf16(h1[0], h1[1]); w.w = cvt_pk_bf16(h1[2], h1[3]);
                *(u32x4*)(H + (size_t)row * ldh + col0) = w; asm volatile("" ::: "memory"); }
    }
};
struct EpiDown {
    static constexpr bool PERM = false, AFTER_DRAIN = false;
    const float* res; float* out; bf16_t* xb; float* ssq; float scale;
    __device__ __forceinline__ void operator()(const f32x4 (&acc)[2][2][4][2], const Unit& u, int wr, int wc, int fr, int fq) const {
        const int row0 = u.pm * BM + wr * 64 + fr, col0 = u.pn * BM + wc * 32 + 4 * fq;
#pragma unroll
        for (int ai = 0; ai < 2; ++ai)
#pragma unroll
            for (int m = 0; m < 4; ++m) { const int row = row0 + ai * HALF + m * 16; const size_t off = (size_t)row * 1024 + col0; float s2 = 0.f;
#pragma unroll
                for (int bj = 0; bj < 2; ++bj)
#pragma unroll
                    for (int n = 0; n < 2; ++n) { const f32x4 r = *(const f32x4*)(res + off + bj * HALF + n * 16); const f32x4 v = r + acc[ai][bj][m][n] * scale;
                        *(f32x4*)(out + off + bj * HALF + n * 16) = v; u32x2 w; w.x = cvt_pk_bf16(v[0], v[1]); w.y = cvt_pk_bf16(v[2], v[3]);
                        *(u32x2*)(xb + off + bj * HALF + n * 16) = w; s2 += (v[0] * v[0] + v[1] * v[1]) + (v[2] * v[2] + v[3] * v[3]); }
                s2 += __shfl_xor(s2, 16); s2 += __shfl_xor(s2, 32);
                if (fq == 0) ssq[(size_t)row * 16 + u.pn * 4 + wc] = s2;
                asm volatile("" ::: "memory"); }
    }
};
struct EpiSguV {
    static constexpr bool PERM = true, AFTER_DRAIN = false;
    bf16_t* VS; const float* ssq; f32x2* stats;
    __device__ __forceinline__ void operator()(const f32x4 (&acc)[2][2][4][2], const Unit& u, int wr, int wc, int fr, int fq) const {
        const int row0 = u.pm * BM + wr * 64 + fr, col0 = u.pn * BM + wc * 32 + 8 * fq;
#pragma unroll
        for (int ai = 0; ai < 2; ++ai)
#pragma unroll
            for (int m = 0; m < 4; ++m) { const int row = row0 + ai * HALF + m * 16; const float rs = row_rstd(ssq, row); float s1 = 0.f, s2 = 0.f;
#pragma unroll
                for (int bj = 0; bj < 2; ++bj) { const f32x4 v0 = gelu4(acc[ai][bj][m][0] * rs), v1 = gelu4(acc[ai][bj][m][1] * rs);
                    s1 += ((v0[0] + v0[1]) + (v0[2] + v0[3])) + ((v1[0] + v1[1]) + (v1[2] + v1[3]));
                    s2 += ((v0[0] * v0[0] + v0[1] * v0[1]) + (v0[2] * v0[2] + v0[3] * v0[3])) + ((v1[0] * v1[0] + v1[1] * v1[1]) + (v1[2] * v1[2] + v1[3] * v1[3]));
                    u32x4 w; w.x = cvt_pk_bf16(v0[0], v0[1]); w.y = cvt_pk_bf16(v0[2], v0[3]); w.z = cvt_pk_bf16(v1[0], v1[1]); w.w = cvt_pk_bf16(v1[2], v1[3]);
                    *(u32x4*)(VS + (size_t)row * 3072 + col0 + bj * HALF) = w; }
                s1 += __shfl_xor(s1, 16); s1 += __shfl_xor(s1, 32); s2 += __shfl_xor(s2, 16); s2 += __shfl_xor(s2, 32);
                if (fq == 0) stats[(size_t)row * 48 + u.pn * 4 + wc] = (f32x2){s1, s2}; asm volatile("" ::: "memory"); }
    }
};
struct EpiSguU {
    static constexpr bool PERM = true, AFTER_DRAIN = false;
    bf16_t* VS; const float* ssq;
    __device__ __forceinline__ void operator()(const f32x4 (&acc)[2][2][4][2], const Unit& u, int wr, int wc, int fr, int fq) const {
        const int row0 = u.pm * BM + wr * 64 + fr, col0 = u.pn * BM + wc * 32 + 8 * fq;
#pragma unroll
        for (int ai = 0; ai < 2; ++ai)
#pragma unroll
            for (int m = 0; m < 4; ++m) { const int row = row0 + ai * HALF + m * 16; const float rs = row_rstd(ssq, row);
#pragma unroll
                for (int bj = 0; bj < 2; ++bj) { u32x4* p = (u32x4*)(VS + (size_t)row * 3072 + col0 + bj * HALF); const u32x4 sv = *p;
                    const f32x4 v0 = gelu4(acc[ai][bj][m][0] * rs), v1 = gelu4(acc[ai][bj][m][1] * rs);
                    u32x4 w; w.x = cvt_pk_bf16(v0[0] * bflo(sv.x), v0[1] * bfhi(sv.x)); w.y = cvt_pk_bf16(v0[2] * bflo(sv.y), v0[3] * bfhi(sv.y));
                    w.z = cvt_pk_bf16(v1[0] * bflo(sv.z), v1[1] * bfhi(sv.z)); w.w = cvt_pk_bf16(v1[2] * bflo(sv.w), v1[3] * bfhi(sv.w));
                    *p = w; } asm volatile("" ::: "memory"); }
    }
};
__device__ __forceinline__ unsigned pk_f16(float a, float b) { const _Float16 ha = (_Float16)a, hb = (_Float16)b; return (unsigned)__builtin_bit_cast(unsigned short, ha) | ((unsigned)__builtin_bit_cast(unsigned short, hb) << 16); }
struct EpiHgrn {
    static constexpr bool PERM = true, AFTER_DRAIN = false;
    bf16_t* O; size_t stride; const float* ssq; const float* lb;
    __device__ __forceinline__ void operator()(const f32x4 (&acc)[2][2][4][2], const Unit& u, int wr, int wc, int fr, int fq) const {
        const int region = u.pn >> 2; const int row0 = u.pm * BM + wr * 64 + fr, col0 = (u.pn & 3) * BM + wc * 32 + 8 * fq;
        bf16_t* base = O + (size_t)region * stride;
        f32x4 l0[2], l1[2];
        if (region == 1 || region == 2) {
#pragma unroll
            for (int bj = 0; bj < 2; ++bj) { l0[bj] = *(const f32x4*)(lb + (region - 1) * 1024 + col0 + bj * HALF); l1[bj] = *(const f32x4*)(lb + (region - 1) * 1024 + col0 + bj * HALF + 4); }
        } else { l0[0] = l0[1] = l1[0] = l1[1] = (f32x4){0.f, 0.f, 0.f, 0.f}; }
#pragma unroll
        for (int ai = 0; ai < 2; ++ai)
#pragma unroll
            for (int m = 0; m < 4; ++m) { const int row = row0 + ai * HALF + m * 16; const float rs = row_rstd(ssq, row);
#pragma unroll
                for (int bj = 0; bj < 2; ++bj) { f32x4 v0 = acc[ai][bj][m][0] * rs, v1 = acc[ai][bj][m][1] * rs; u32x4 w;
                    if (region == 1 || region == 2) {
#pragma unroll
                        for (int j = 0; j < 4; ++j) { const float sg0 = __builtin_amdgcn_rcpf(1.0f + __expf(-v0[j])), sg1 = __builtin_amdgcn_rcpf(1.0f + __expf(-v1[j]));
                            v0[j] = __logf(l0[bj][j] + (1.0f - l0[bj][j]) * sg0); v1[j] = __logf(l1[bj][j] + (1.0f - l1[bj][j]) * sg1); }
                        w.x = pk_f16(v0[0], v0[1]); w.y = pk_f16(v0[2], v0[3]); w.z = pk_f16(v1[0], v1[1]); w.w = pk_f16(v1[2], v1[3]);
                    } else {
                        if (region != 3) { v0 = silu4(v0); v1 = silu4(v1); }
                        w.x = cvt_pk_bf16(v0[0], v0[1]); w.y = cvt_pk_bf16(v0[2], v0[3]); w.z = cvt_pk_bf16(v1[0], v1[1]); w.w = cvt_pk_bf16(v1[2], v1[3]);
                    }
                    *(u32x4*)(base + (size_t)row * 1024 + col0 + bj * HALF) = w; } asm volatile("" ::: "memory"); }
    }
};

template <class Epi, class Sched, bool ALIGN_EPI = false, bool SP2 = false>
__device__ __forceinline__ void gemm_phase(PG8_LAS unsigned char* lds, const Gemm g, const Sched& S, const Epi& E, int wave_s) {
    int tid_; { int l_; asm volatile("v_mbcnt_lo_u32_b32 %0, -1, 0\n\tv_mbcnt_hi_u32_b32 %0, -1, %0" : "=v"(l_)); tid_ = wave_s * 64 + l_; }
    const int tid = tid_, wid = wave_s, lane = tid & 63, wr = wid >> 2, wc = wid & 3, fr = lane & 15, fq = lane >> 4;
    const int K = g.K, nt = K / BK;
    unsigned voffA[2], voffB[2];
#pragma unroll
    for (int i = 0; i < 2; ++i) { int R, C; stage_rc(tid * 16 + i * 8192, R, C); const int Rb = Epi::PERM ? ((R & ~31) + perm32(R & 31)) : R;
        voffA[i] = (unsigned)(R * K + C) * 2u; voffB[i] = (unsigned)(Rb * K + C) * 2u; }
    const size_t kstep = (size_t)(BK * 2);
    const size_t hstep = (size_t)HALF * K * 2;
    const size_t tstep = 2 * hstep;
    const unsigned ldsw = (unsigned)wid * 1024u;
    const int aoff = lds_byte(wr * 64 + fr, fq * 8), boff = lds_byte(wc * 32 + fr, fq * 8);
#define PG8_SA(b, h) (((b) * 2 + (h)) * HTB)
#define PG8_SB(b, h) ((4 + (b) * 2 + (h)) * HTB)
#define PG8_STAGE(bufoff, gbase, voff) do { _Pragma("unroll") for (int _i = 0; _i < 2; ++_i) \
        __builtin_amdgcn_global_load_lds((const unsigned*)((const char*)(gbase) + (voff)[_i]), (PG8_LAS unsigned*)(lds + (bufoff) + ldsw + _i * 8192), 16, 0, 0); } while (0)
#define PG8_LDA(dst, b, h) do { _Pragma("unroll") for (int m = 0; m < 4; ++m) _Pragma("unroll") for (int k = 0; k < 2; ++k) dst[m][k] = *(const PG8_LAS bf16x8*)(lds + PG8_SA(b, h) + aoff + m * 2048 + k * 1024); } while (0)
#define PG8_LDB(dst, b, h) do { _Pragma("unroll") for (int n = 0; n < 2; ++n) _Pragma("unroll") for (int k = 0; k < 2; ++k) dst[n][k] = *(const PG8_LAS bf16x8*)(lds + PG8_SB(b, h) + boff + n * 2048 + k * 1024); } while (0)
#define PG8_MMA(ai, bj, At, Bt) do { __builtin_amdgcn_s_setprio(1); _Pragma("unroll") for (int m = 0; m < 4; ++m) _Pragma("unroll") for (int n = 0; n < 2; ++n) _Pragma("unroll") for (int k = 0; k < 2; ++k) \
        acc[ai][bj][m][n] = __builtin_amdgcn_mfma_f32_16x16x32_bf16(Bt[n][k], At[m][k], acc[ai][bj][m][n], 0, 0, 0); __builtin_amdgcn_s_setprio(0); } while (0)
#define PG8_WAIT_V(n) asm volatile("s_waitcnt vmcnt(" #n ")" ::: "memory")
#define PG8_WAIT_L(n) asm volatile("s_waitcnt lgkmcnt(" #n ")" ::: "memory")
#define PG8_BAR __builtin_amdgcn_s_barrier()
#define PG8_SCHED __builtin_amdgcn_sched_barrier(0)
    Unit cur, nxt; int ui = 0;
    if (!S.next(0, cur)) return;
    f32x4 acc[2][2][4][2];
#pragma unroll
    for (int a = 0; a < 2; ++a)
#pragma unroll
        for (int b = 0; b < 2; ++b)
#pragma unroll
            for (int m = 0; m < 4; ++m)
#pragma unroll
                for (int n = 0; n < 2; ++n) acc[a][b][m][n] = (f32x4){0.f, 0.f, 0.f, 0.f};
    bf16x8 At[4][2], B0[2][2], B1[2][2];
    const char* cA = (const char*)g.A + (size_t)cur.pm * tstep; const char* cB = (const char*)g.Bt + (size_t)cur.pn * tstep;
    S.a_ready(cur);
    if constexpr (SP2) {
        PG8_STAGE(PG8_SB(0, 0), cB, voffB); PG8_STAGE(PG8_SB(0, 1), cB + hstep, voffB); PG8_STAGE(PG8_SA(0, 0), cA, voffA); PG8_STAGE(PG8_SA(0, 1), cA + hstep, voffA);
        if (wr == 1) PG8_BAR;
        PG8_WAIT_V(2); PG8_BAR;
        PG8_STAGE(PG8_SB(1, 0), cB + kstep, voffB); PG8_STAGE(PG8_SA(1, 0), cA + kstep, voffA); PG8_STAGE(PG8_SB(1, 1), cB + hstep + kstep, voffB);
        PG8_WAIT_V(6); PG8_BAR;
    } else {
        PG8_STAGE(PG8_SB(0, 0), cB, voffB); PG8_STAGE(PG8_SA(0, 0), cA, voffA); PG8_STAGE(PG8_SB(0, 1), cB + hstep, voffB); PG8_STAGE(PG8_SA(0, 1), cA + hstep, voffA);
        if (wr == 1) PG8_BAR;
        PG8_WAIT_V(4); PG8_BAR;
        PG8_STAGE(PG8_SB(1, 0), cB + kstep, voffB); PG8_STAGE(PG8_SA(1, 0), cA + kstep, voffA); PG8_STAGE(PG8_SB(1, 1), cB + hstep + kstep, voffB);
        PG8_WAIT_V(6); PG8_BAR;
    }
    for (;;) {
        const bool has_next = S.next(ui + 1, nxt);
        const char* nA = has_next ? (const char*)g.A + (size_t)nxt.pm * tstep : cA; const char* nB = has_next ? (const char*)g.Bt + (size_t)nxt.pn * tstep : cB;
        for (int t = 0; t < nt; t += 2) {
            const bool last = (t == nt - 2);
            const char* a1 = cA + (size_t)(t + 1) * kstep;
            const char* a2 = last ? nA : cA + (size_t)(t + 2) * kstep; const char* b2 = last ? nB : cB + (size_t)(t + 2) * kstep;
            const char* a3 = a2 + kstep; const char* b3 = b2 + kstep;
            if (last && has_next) S.a_ready(nxt);
            if constexpr (SP2) {
            PG8_LDB(B0, 0, 0); PG8_LDB(B1, 0, 1); PG8_SCHED; PG8_LDA(At, 0, 0); PG8_STAGE(PG8_SA(1, 1), a1 + hstep, voffA);
            PG8_WAIT_V(8); PG8_WAIT_L(0); PG8_BAR; PG8_MMA(0, 0, At, B0); PG8_MMA(0, 1, At, B1); PG8_BAR; PG8_SCHED;
            PG8_LDA(At, 0, 1); PG8_STAGE(PG8_SB(0, 0), b2, voffB); PG8_STAGE(PG8_SB(0, 1), b2 + hstep, voffB); PG8_STAGE(PG8_SA(0, 0), a2, voffA);
            PG8_WAIT_V(8); PG8_WAIT_L(0); PG8_BAR; PG8_MMA(1, 0, At, B0); PG8_MMA(1, 1, At, B1); PG8_BAR; PG8_SCHED;
            PG8_LDB(B0, 1, 0); PG8_LDB(B1, 1, 1); PG8_SCHED; PG8_LDA(At, 1, 0); PG8_STAGE(PG8_SA(0, 1), a2 + hstep, voffA);
            PG8_WAIT_V(8); PG8_WAIT_L(0); PG8_BAR; PG8_MMA(0, 0, At, B0); PG8_MMA(0, 1, At, B1); PG8_BAR; PG8_SCHED;
            PG8_LDA(At, 1, 1); PG8_STAGE(PG8_SB(1, 0), b3, voffB); PG8_STAGE(PG8_SB(1, 1), b3 + hstep, voffB); PG8_STAGE(PG8_SA(1, 0), a3, voffA);
            PG8_WAIT_V(8); PG8_WAIT_L(0); PG8_BAR; PG8_MMA(1, 0, At, B0); PG8_MMA(1, 1, At, B1); PG8_BAR; PG8_SCHED;
            } else {
            PG8_LDB(B0, 0, 0); PG8_SCHED; PG8_LDA(At, 0, 0); PG8_STAGE(PG8_SA(1, 1), a1 + hstep, voffA);
            PG8_WAIT_L(8); PG8_BAR; PG8_WAIT_L(0); PG8_MMA(0, 0, At, B0); PG8_BAR; PG8_SCHED;
            PG8_LDB(B1, 0, 1); PG8_STAGE(PG8_SB(0, 0), b2, voffB);
            PG8_BAR; PG8_WAIT_L(0); PG8_MMA(0, 1, At, B1); PG8_BAR;
            PG8_LDA(At, 0, 1); PG8_STAGE(PG8_SA(0, 0), a2, voffA);
            PG8_BAR; PG8_WAIT_L(0); PG8_MMA(1, 0, At, B0); PG8_BAR; PG8_SCHED;
            PG8_STAGE(PG8_SB(0, 1), b2 + hstep, voffB);
            PG8_WAIT_V(6); PG8_BAR; PG8_MMA(1, 1, At, B1); PG8_BAR;
            PG8_LDB(B0, 1, 0); PG8_SCHED; PG8_LDA(At, 1, 0); PG8_STAGE(PG8_SA(0, 1), a2 + hstep, voffA);
            PG8_WAIT_L(8); PG8_BAR; PG8_WAIT_L(0); PG8_MMA(0, 0, At, B0); PG8_BAR; PG8_SCHED;
            PG8_LDB(B1, 1, 1); PG8_STAGE(PG8_SB(1, 0), b3, voffB);
            PG8_BAR; PG8_WAIT_L(0); PG8_MMA(0, 1, At, B1); PG8_BAR;
            PG8_LDA(At, 1, 1); PG8_STAGE(PG8_SA(1, 0), a3, voffA);
            PG8_BAR; PG8_WAIT_L(0); PG8_MMA(1, 0, At, B0); PG8_BAR; PG8_SCHED;
            PG8_STAGE(PG8_SB(1, 1), b3 + hstep, voffB);
            PG8_WAIT_V(6); PG8_BAR; PG8_MMA(1, 1, At, B1); PG8_BAR;
            }
        }
        if constexpr (ALIGN_EPI) { if (wr == 0) PG8_BAR; }
        if constexpr (!Epi::AFTER_DRAIN) { E(acc, cur, wr, wc, fr, fq); S.done(cur); }
        if (!has_next) break;
#pragma unroll
        for (int a = 0; a < 2; ++a)
#pragma unroll
            for (int b = 0; b < 2; ++b)
#pragma unroll
                for (int m = 0; m < 4; ++m)
#pragma unroll
                    for (int n = 0; n < 2; ++n) acc[a][b][m][n] = (f32x4){0.f, 0.f, 0.f, 0.f};
        cur = nxt; cA = nA; cB = nB; ++ui;
        if constexpr (ALIGN_EPI) { if (wr == 1) PG8_BAR; }
    }
    PG8_WAIT_V(0);
    if constexpr (!ALIGN_EPI) { if (wr == 0) PG8_BAR; }
    PG8_BAR;
    if constexpr (Epi::AFTER_DRAIN) { E.fused(acc, cur, wr, wc, fr, fq, lds, wid, lane); S.done(cur); }
#undef PG8_SA
#undef PG8_SB
#undef PG8_STAGE
#undef PG8_LDA
#undef PG8_LDB
#undef PG8_MMA
#undef PG8_WAIT_V
#undef PG8_WAIT_L
#undef PG8_BAR
#undef PG8_SCHED
}
}

#define LAS __attribute__((address_space(3)))
using pg8::bf16_t; using pg8::bf16x8; using pg8::f32x4; using pg8::f32x2; using pg8::u32x4; using pg8::u32x2;
constexpr int NTHR = 512;
constexpr int D = 1024, FF = 2816, SGD = 3072, SLAB = 32768, HSL = 16384;
constexpr int LDS_BYTES = 155648;
constexpr int TS = 272;
constexpr size_t MiB = 1u << 20;
constexpr size_t WS_LB = 0;
constexpr size_t WS_DEC = 1 * MiB;
constexpr size_t WS_SSQ = 4 * MiB;
constexpr size_t WS_STAT = 8 * MiB;
constexpr size_t WS_WB = 24 * MiB;
constexpr size_t WS_XB = 120 * MiB;
constexpr size_t WS_BIG = 184 * MiB;
constexpr size_t WS_END = 504 * MiB;
constexpr size_t WB_FFN = 0, WB_FFN_STRIDE = 8650752, WB_DN_OFF = 5767168;
constexpr size_t WB_SGU_IN = 34603008, WB_SGU_OUT = 40894464, WB_HG_IN = 44040192, WB_HG_OUT = 49283072;

struct Args { const float* in[17]; float* out; unsigned char* ws; };

#define LDS_WAIT() asm volatile("s_waitcnt lgkmcnt(0)" ::: "memory")
__device__ __forceinline__ unsigned f2bf(float f) { unsigned u = __builtin_bit_cast(unsigned, f); return (u + 0x7fffu + ((u >> 16) & 1u)) >> 16; }
#ifdef HG_CLAMP_G
__device__ __forceinline__ float h2f(unsigned short h) { const float v = (float)__builtin_bit_cast(_Float16, h); return (v >= -1.2f && v <= 0.f) ? v : -0.3f; }
#else
__device__ __forceinline__ float h2f(unsigned short h) { return (float)__builtin_bit_cast(_Float16, h); }
#endif
__device__ __forceinline__ int lane_id() { int r; asm volatile("v_mbcnt_lo_u32_b32 %0, -1, 0\n\tv_mbcnt_hi_u32_b32 %0, -1, %0" : "=v"(r)); return r; }
__device__ __forceinline__ float wave_sum(float v) {
#pragma unroll
    for (int o = 1; o < 64; o <<= 1) v += __shfl_xor(v, o);
    return v;
}

__device__ __forceinline__ void conv_item(const float* W, int ldw, int sc0, int K, const float* scale, bf16_t* WT, int n0, int k0, LAS float* scr, int lane) {
#pragma unroll 8
    for (int i = 0; i < 32; ++i) { const int kk = 2 * i + (lane >> 5); float v = W[(size_t)(k0 + kk) * ldw + sc0 + (lane & 31)]; if (scale) v *= scale[k0 + kk]; scr[kk * 33 + (lane & 31)] = v; }
    LDS_WAIT(); asm volatile("" ::: "memory");
    const int c = lane & 7;
#pragma unroll
    for (int j = 0; j < 4; ++j) { const int n = (lane >> 3) + 8 * j; const LAS float* s = scr + (8 * c) * 33 + n;
        u32x4 o; o.x = pg8::cvt_pk_bf16(s[0 * 33], s[1 * 33]); o.y = pg8::cvt_pk_bf16(s[2 * 33], s[3 * 33]); o.z = pg8::cvt_pk_bf16(s[4 * 33], s[5 * 33]); o.w = pg8::cvt_pk_bf16(s[6 * 33], s[7 * 33]);
        *(u32x4*)(WT + (size_t)(n0 + n) * K + k0 + 8 * c) = o; }
    LDS_WAIT(); asm volatile("" ::: "memory");
}
__device__ __forceinline__ void conv_matrix(int mode, const float* src0, const float* src1, int ldw, int K, int Ndst, const float* scale, bf16_t* dst, LAS float* scr, int gw, int ngw, int lane) {
    const int nblk = Ndst / 32, nitems = (K / 64) * nblk;
    for (int it = gw; it < nitems; it += ngw) {
        const int kb = it / nblk, nb = it % nblk, n0 = 32 * nb;
        const float* src = src0; int sc0 = n0;
        if (mode == 1) { const int tile = n0 >> 8, half = (n0 >> 7) & 1, i0 = n0 & 127; src = half ? src1 : src0; sc0 = 128 * tile + i0; }
        conv_item(src, ldw, sc0, K, scale, dst, n0, 64 * kb, scr, lane);
    }
}

__device__ __forceinline__ void prep_rows(const float* x, bf16_t* xb, float* ssq, int nrows, int gw, int ngw) {
    int lane = lane_id(); asm volatile("" : "+v"(lane)); asm volatile("" : "+s"(gw));
    for (int m = gw; m < nrows; m += ngw) {
        const f32x4* xr = (const f32x4*)(x + (size_t)m * D) + lane; u32x2* o = (u32x2*)(xb + (size_t)m * D) + lane;
#pragma unroll
        for (int j = 0; j < 4; ++j) { const f32x4 v = xr[64 * j]; u32x2 w; w.x = pg8::cvt_pk_bf16(v[0], v[1]); w.y = pg8::cvt_pk_bf16(v[2], v[3]); o[64 * j] = w;
            const float s = wave_sum((v[0] * v[0] + v[1] * v[1]) + (v[2] * v[2] + v[3] * v[3]));
            if (lane < 4) ssq[(size_t)m * 16 + 4 * j + lane] = (lane == 0) ? s : 0.f; }
    }
}
__device__ __forceinline__ void final_rows(float* x, const float* ssq, const float* fw, int nrows, int gw, int ngw) {
    int lane = lane_id(); asm volatile("" : "+v"(lane)); asm volatile("" : "+s"(gw));
    for (int m = gw; m < nrows; m += ngw) {
        const float rs = pg8::row_rstd(ssq, m);
        f32x4* xr = (f32x4*)(x + (size_t)m * D) + lane; const f32x4* wr = (const f32x4*)fw + lane;
#pragma unroll
        for (int j = 0; j < 4; ++j) { const f32x4 v = xr[64 * j]; xr[64 * j] = v * rs * wr[64 * j]; }
    }
}

__device__ __forceinline__ void load_tile_T(LAS unsigned char* T, const bf16_t* src, size_t pitch, int tid) {
#pragma unroll
    for (int i = 0; i < 4; ++i) { const int idx = tid + NTHR * i, s = idx & 127, cq = idx >> 7;
        const u32x4 v = *(const u32x4*)(src + (size_t)s * pitch + cq * 8);
        LAS unsigned short* p = (LAS unsigned short*)(T + (cq * 8) * TS + s * 2);
        p[0 * (TS / 2)] = (unsigned short)(v.x & 0xffff); p[1 * (TS / 2)] = (unsigned short)(v.x >> 16);
        p[2 * (TS / 2)] = (unsigned short)(v.y & 0xffff); p[3 * (TS / 2)] = (unsigned short)(v.y >> 16);
        p[4 * (TS / 2)] = (unsigned short)(v.z & 0xffff); p[5 * (TS / 2)] = (unsigned short)(v.z >> 16);
        p[6 * (TS / 2)] = (unsigned short)(v.w & 0xffff); p[7 * (TS / 2)] = (unsigned short)(v.w >> 16); }
}
#define FRAG(base, row, kk) (*(const LAS bf16x8*)((base) + (row) * TS + ((kk) * 32 + 8 * fq) * 2))

__device__ __forceinline__ void sgu_mix(LAS unsigned char* lds, bf16_t* VS, const f32x2* stats, const float* w_s, const float* b_s, const float* lng, const float* lnb, int G, int bid, int wave) {
    int tid = wave * 64 + lane_id();
    const int lane = tid & 63, wid = tid >> 6, wr = wid >> 2, wc = wid & 3, fr = lane & 15, fq = lane >> 4;
    LAS unsigned char* WT = lds; LAS unsigned char* VT = lds + 34816;
    LAS float* MU = (LAS float*)(lds + 69632); LAS float* RS = MU + 128; LAS float* MT = MU + 256; LAS float* RWS = MU + 384;
#pragma unroll 1
    for (int chunk = bid; chunk < SLAB / 128; chunk += G) {
        const int r0 = chunk * 128;
        if (tid < 128) { const f32x2* sp = stats + (size_t)(r0 + tid) * 48; float s1 = 0.f, s2 = 0.f;
#pragma unroll 8
            for (int j = 0; j < 48; ++j) { const f32x2 v = sp[j]; s1 += v.x; s2 += v.y; }
            const float mu = s1 * (1.0f / 3072.0f); const float var = s2 * (1.0f / 3072.0f) - mu * mu; MU[tid] = mu; RS[tid] = rsqrtf(fmaxf(var, 0.f) + 1e-6f); }
        __syncthreads();
        u32x4 nv[4];
#pragma unroll
        for (int i = 0; i < 4; ++i) { const int idx = tid + NTHR * i; nv[i] = *(const u32x4*)(VS + (size_t)(r0 + (idx & 127)) * SGD + (idx >> 7) * 8); }
#pragma unroll 1
        for (int tile = 0; tile < 24; ++tile) {
            const int g = tile / 3, c0 = tile * 128;
            if (tile % 3 == 0) { const int t = tid >> 2, sq = tid & 3; const float* wrow = w_s + ((size_t)g * 128 + t) * 128 + sq * 32; float macc = 0.f, rw = 0.f;
#pragma unroll
                for (int i = 0; i < 4; ++i) { const f32x4 a = *(const f32x4*)(wrow + 8 * i), b = *(const f32x4*)(wrow + 8 * i + 4); const int s0 = sq * 32 + 8 * i;
                    rw += ((a[0] + a[1]) + (a[2] + a[3])) + ((b[0] + b[1]) + (b[2] + b[3]));
                    u32x4 w; w.x = pg8::cvt_pk_bf16(a[0] * RS[s0 + 0], a[1] * RS[s0 + 1]); w.y = pg8::cvt_pk_bf16(a[2] * RS[s0 + 2], a[3] * RS[s0 + 3]);
                    w.z = pg8::cvt_pk_bf16(b[0] * RS[s0 + 4], b[1] * RS[s0 + 5]); w.w = pg8::cvt_pk_bf16(b[2] * RS[s0 + 6], b[3] * RS[s0 + 7]);
                    macc += pg8::bflo(w.x) * MU[s0 + 0] + pg8::bfhi(w.x) * MU[s0 + 1] + pg8::bflo(w.y) * MU[s0 + 2] + pg8::bfhi(w.y) * MU[s0 + 3]
                          + pg8::bflo(w.z) * MU[s0 + 4] + pg8::bfhi(w.z) * MU[s0 + 5] + pg8::bflo(w.w) * MU[s0 + 6] + pg8::bfhi(w.w) * MU[s0 + 7];
                    *(LAS u32x4*)(WT + t * TS + s0 * 2) = w; }
                macc += __shfl_xor(macc, 1); macc += __shfl_xor(macc, 2); rw += __shfl_xor(rw, 1); rw += __shfl_xor(rw, 2);
                if (sq == 0) { MT[t] = macc; RWS[t] = rw; } }
#pragma unroll
            for (int i = 0; i < 4; ++i) { const int idx = tid + NTHR * i, s = idx & 127, cq = idx >> 7; const u32x4 v = nv[i];
                LAS unsigned short* p = (LAS unsigned short*)(VT + (cq * 8) * TS + s * 2);
                p[0 * (TS / 2)] = (unsigned short)(v.x & 0xffff); p[1 * (TS / 2)] = (unsigned short)(v.x >> 16);
                p[2 * (TS / 2)] = (unsigned short)(v.y & 0xffff); p[3 * (TS / 2)] = (unsigned short)(v.y >> 16);
                p[4 * (TS / 2)] = (unsigned short)(v.z & 0xffff); p[5 * (TS / 2)] = (unsigned short)(v.z >> 16);
                p[6 * (TS / 2)] = (unsigned short)(v.w & 0xffff); p[7 * (TS / 2)] = (unsigned short)(v.w >> 16); }
            __syncthreads();
            if (tile + 1 < 24) {
#pragma unroll
                for (int i = 0; i < 4; ++i) { const int idx = tid + NTHR * i; nv[i] = *(const u32x4*)(VS + (size_t)(r0 + (idx & 127)) * SGD + c0 + 128 + (idx >> 7) * 8); } }
            f32x4 acc[4][2];
#pragma unroll
            for (int m = 0; m < 4; ++m) { acc[m][0] = (f32x4){0.f, 0.f, 0.f, 0.f}; acc[m][1] = (f32x4){0.f, 0.f, 0.f, 0.f}; }
#pragma unroll
            for (int kk = 0; kk < 4; ++kk) { bf16x8 Af[4], Bf[2];
#pragma unroll
                for (int m = 0; m < 4; ++m) Af[m] = FRAG(WT, 64 * wr + 16 * m + fr, kk);
#pragma unroll
                for (int n = 0; n < 2; ++n) Bf[n] = FRAG(VT, 32 * wc + 16 * n + fr, kk);
#pragma unroll
                for (int m = 0; m < 4; ++m)
#pragma unroll
                    for (int n = 0; n < 2; ++n) acc[m][n] = __builtin_amdgcn_mfma_f32_16x16x32_bf16(Bf[n], Af[m], acc[m][n], 0, 0, 0); }
#pragma unroll
            for (int m = 0; m < 4; ++m) { const int t = 64 * wr + 16 * m + fr; const float mt = MT[t], rwt = RWS[t], bst = b_s[g * 128 + t];
#pragma unroll
                for (int n = 0; n < 2; ++n) { const int c4 = c0 + 32 * wc + 16 * n + 4 * fq; const f32x4 lg = *(const f32x4*)(lng + c4), lb = *(const f32x4*)(lnb + c4);
                    const f32x4 v = lg * (acc[m][n] - mt) + lb * rwt + bst; u32x2 w; w.x = pg8::cvt_pk_bf16(v[0], v[1]); w.y = pg8::cvt_pk_bf16(v[2], v[3]);
                    *(u32x2*)(VS + (size_t)(r0 + t) * SGD + c4) = w; } }
            __syncthreads();
        }
    }
}

__device__ __forceinline__ void hgrn_pass_a(LAS unsigned char* lds, const bf16_t* GF, const bf16_t* GB, const bf16_t* IV, bf16_t* ST, float* DEC, int G, int bid, int wave) {
    int tid = wave * 64 + lane_id();
    const int lane = tid & 63, wid = tid >> 6, wr = wid >> 2, wc = wid & 3, fr = lane & 15, fq = lane >> 4;
    LAS unsigned char* VT = lds; LAS unsigned char* KT = lds + 34816; LAS float* PART = (LAS float*)(lds + 69632);
    const int k = tid & 127, qr = tid >> 7;
#pragma unroll 1
    for (int item = bid; item < 1024; item += G) {
        const int seg = item >> 3, h = item & 7, r0 = seg * 128, cb = h * 128;
        load_tile_T(VT, IV + (size_t)r0 * D + cb, D, tid);
#pragma unroll 1
        for (int dir = 0; dir < 2; ++dir) {
            const bf16_t* Gp = (dir ? GB : GF) + (size_t)(r0 + 32 * qr) * D + cb + k;
            unsigned short graw[32]; float sum = 0.f;
#pragma unroll
            for (int i = 0; i < 32; ++i) graw[i] = Gp[(size_t)i * D];
#pragma unroll
            for (int i = 0; i < 32; ++i) sum += h2f(graw[i]);
            PART[qr * 128 + k] = sum;
            __syncthreads();
            const float p0 = PART[k], p1 = PART[128 + k], p2 = PART[256 + k], p3 = PART[384 + k];
            LAS unsigned* kt = (LAS unsigned*)(KT + k * TS + 64 * qr);
            if (dir == 0) {
                float run = (qr == 0) ? (p1 + p2 + p3) : (qr == 1) ? (p2 + p3) : (qr == 2) ? p3 : 0.f;
#pragma unroll
                for (int i = 15; i >= 0; --i) { const float g1 = h2f(graw[2 * i + 1]), g0 = h2f(graw[2 * i]);
                    const float e1 = (1.0f - __expf(g1)) * __expf(run); run += g1; const float e0 = (1.0f - __expf(g0)) * __expf(run); run += g0;
                    kt[i] = pg8::cvt_pk_bf16(e0, e1); }
            } else {
                float run = (qr == 0) ? 0.f : (qr == 1) ? p0 : (qr == 2) ? (p0 + p1) : (p0 + p1 + p2);
#pragma unroll
                for (int i = 0; i < 16; ++i) { const float g0 = h2f(graw[2 * i]), g1 = h2f(graw[2 * i + 1]);
                    const float e0 = (1.0f - __expf(g0)) * __expf(run); run += g0; const float e1 = (1.0f - __expf(g1)) * __expf(run); run += g1;
                    kt[i] = pg8::cvt_pk_bf16(e0, e1); }
            }
            const size_t idx = ((size_t)(seg * 8 + h) * 2 + dir);
            if (qr == 0) DEC[idx * 128 + k] = __expf((p0 + p1) + (p2 + p3));
            __syncthreads();
            f32x4 acc[4][2];
#pragma unroll
            for (int m = 0; m < 4; ++m) { acc[m][0] = (f32x4){0.f, 0.f, 0.f, 0.f}; acc[m][1] = (f32x4){0.f, 0.f, 0.f, 0.f}; }
#pragma unroll
            for (int kk = 0; kk < 4; ++kk) { bf16x8 Af[4], Bf[2];
#pragma unroll
                for (int m = 0; m < 4; ++m) Af[m] = FRAG(KT, 64 * wr + 16 * m + fr, kk);
#pragma unroll
                for (int n = 0; n < 2; ++n) Bf[n] = FRAG(VT, 32 * wc + 16 * n + fr, kk);
#pragma unroll
                for (int m = 0; m < 4; ++m)
#pragma unroll
                    for (int n = 0; n < 2; ++n) acc[m][n] = __builtin_amdgcn_mfma_f32_16x16x32_bf16(Af[m], Bf[n], acc[m][n], 0, 0, 0); }
            bf16_t* so = ST + idx * 16384;
#pragma unroll
            for (int m = 0; m < 4; ++m)
#pragma unroll
                for (int n = 0; n < 2; ++n) { const int v = 32 * wc + 16 * n + fr, k4 = 64 * wr + 16 * m + 4 * fq; u32x2 w; w.x = pg8::cvt_pk_bf16(acc[m][n][0], acc[m][n][1]); w.y = pg8::cvt_pk_bf16(acc[m][n][2], acc[m][n][3]);
                    *(u32x2*)(so + v * 128 + k4) = w; }
            __syncthreads();
        }
    }
}
__device__ __forceinline__ void hgrn_pass_b(bf16_t* ST, const float* DEC, int nseq, int nseg, int G, int bid, int wave) {
    int tid = wave * 64 + lane_id();
    const int total = nseq * 16 * 4096;
    for (int w = bid * NTHR + tid; w < total; w += G * NTHR) {
        const int e4 = w & 4095, sh = w >> 12, dir = sh & 1, h = (sh >> 1) & 7, seq = sh >> 4, k0 = (e4 * 4) & 127;
        f32x4 S = (f32x4){0.f, 0.f, 0.f, 0.f};
#pragma unroll 4
        for (int j = 0; j < nseg; ++j) { const int segi = dir ? (nseg - 1 - j) : j; const size_t idx = ((size_t)((seq * nseg + segi) * 8 + h) * 2 + dir);
            u32x2* p = (u32x2*)(ST + idx * 16384 + e4 * 4); const u32x2 uv = *p; const f32x4 d = *(const f32x4*)(DEC + idx * 128 + k0);
            u32x2 o; o.x = pg8::cvt_pk_bf16(S[0], S[1]); o.y = pg8::cvt_pk_bf16(S[2], S[3]); *p = o;
            S = d * S + (f32x4){pg8::bflo(uv.x), pg8::bfhi(uv.x), pg8::bflo(uv.y), pg8::bfhi(uv.y)}; }
    }
}
__device__ __forceinline__ void hgrn_pass_c(LAS unsigned char* lds, const bf16_t* QSg, const bf16_t* GF, const bf16_t* GB, const bf16_t* IV, const bf16_t* GS, const bf16_t* ST, const float* normw, bf16_t* OB, int G, int bid, int wave) {
    int tid = wave * 64 + lane_id();
    const int lane = tid & 63, wid = tid >> 6, wr = wid >> 2, wc = wid & 3, fr = lane & 15, fq = lane >> 4;
    LAS unsigned char* QS = lds; LAS unsigned char* PP = lds + 34816; LAS unsigned char* Q1 = lds + 69632; LAS unsigned char* KDA = lds + 87040;
    LAS unsigned char* KEA = lds + 104448; LAS unsigned char* KDB = lds + 121856; LAS unsigned char* STL = Q1; LAS unsigned char* VT = KEA;
    LAS float* PART = (LAS float*)(lds + 139264); LAS float* RED = (LAS float*)(lds + 141312);
    const int k = tid & 127, qr = tid >> 7;
#pragma unroll 1
    for (int item = bid; item < 1024; item += G) {
        const int seg = item >> 3, h = item & 7, r0 = seg * 128, cb = h * 128;
        f32x4 acc[4][2];
#pragma unroll
        for (int m = 0; m < 4; ++m) { acc[m][0] = (f32x4){0.f, 0.f, 0.f, 0.f}; acc[m][1] = (f32x4){0.f, 0.f, 0.f, 0.f}; }
#pragma unroll 1
        for (int dir = 0; dir < 2; ++dir) {
            const bf16_t* Gp = (dir ? GB : GF) + (size_t)r0 * D + cb + k; const bf16_t* Qp = QSg + (size_t)r0 * D + cb + k;
            {
                unsigned short graw[32], qraw[32]; float sum = 0.f;
#pragma unroll
                for (int i = 0; i < 32; ++i) { const int p = 32 * qr + i, t = dir ? (127 - p) : p; graw[i] = Gp[(size_t)t * D]; qraw[i] = Qp[(size_t)t * D]; }
#pragma unroll
                for (int i = 0; i < 32; ++i) sum += h2f(graw[i]);
                PART[qr * 128 + k] = sum;
                __syncthreads();
                float run = (qr & 1) ? PART[(qr - 1) * 128 + k] : 0.f;
                const float r1 = PART[k] + PART[128 + k];
                const bool inB = qr >= 2;
#pragma unroll
                for (int i = 0; i < 32; ++i) { const int p = 32 * qr + i, t = dir ? (127 - p) : p, tl = t & 63; const float gi = h2f(graw[i]); run += gi;
                    const float q = pg8::bf2f(qraw[i]); const float kkv = 1.0f - __expf(gi); const float ep = __expf(run), em = __expf(-run);
                    if (!inB) {
                        *((LAS unsigned short*)(QS + t * TS) + k) = (unsigned short)f2bf(q * ep);
                        *((LAS unsigned short*)(KDA + tl * TS) + k) = (unsigned short)f2bf(kkv * em);
                        *((LAS unsigned short*)(KEA + tl * TS) + k) = (unsigned short)f2bf(kkv * __expf(r1 - run));
                    } else {
                        *((LAS unsigned short*)(Q1 + tl * TS) + k) = (unsigned short)f2bf(q * ep);
                        *((LAS unsigned short*)(QS + t * TS) + k) = (unsigned short)f2bf(q * __expf(r1 + run));
                        *((LAS unsigned short*)(KDB + tl * TS) + k) = (unsigned short)f2bf(kkv * em);
                    } }
            }
            __syncthreads();
            {
                const int ct = wid >> 2; const bool tA = (ct == dir);
                const LAS unsigned char* qb = tA ? (QS + (16 * wid) * TS) : (Q1 + ((16 * wid) & 63) * TS);
                bf16x8 Qf[4];
#pragma unroll
                for (int kk = 0; kk < 4; ++kk) Qf[kk] = FRAG(qb, fr, kk);
                const int t = 16 * wid + fr;
#pragma unroll
                for (int j = 0; j < 8; ++j) { const int cs = j >> 2; const bool sA = (cs == dir);
                    f32x4 pacc = (f32x4){0.f, 0.f, 0.f, 0.f};
                    if (!(tA && !sA)) {
                        const LAS unsigned char* kb = (tA ? KDA : (sA ? KEA : KDB)) + ((16 * j) & 63) * TS;
#pragma unroll
                        for (int kk = 0; kk < 4; ++kk) pacc = __builtin_amdgcn_mfma_f32_16x16x32_bf16(FRAG(kb, fr, kk), Qf[kk], pacc, 0, 0, 0);
                        if (tA == sA) {
#pragma unroll
                            for (int r = 0; r < 4; ++r) { const int s = 16 * j + 4 * fq + r; const bool keep = dir ? (s >= t) : (s <= t); if (!keep) pacc[r] = 0.f; }
                        }
                    }
#ifdef HG_SAN_P
                    for (int r = 0; r < 4; ++r) if (!(fabsf(pacc[r]) < 1e6f)) pacc[r] = 0.f;
#endif
                    u32x2 w; w.x = pg8::cvt_pk_bf16(pacc[0], pacc[1]); w.y = pg8::cvt_pk_bf16(pacc[2], pacc[3]);
                    *(LAS u32x2*)(PP + t * TS + (16 * j + 4 * fq) * 2) = w; }
            }
            __syncthreads();
            {
                const u32x4* sg = (const u32x4*)(ST + ((size_t)(seg * 8 + h) * 2 + dir) * 16384);
#pragma unroll
                for (int i = 0; i < 4; ++i) { const int c = tid + NTHR * i; u32x4 sv = sg[c];
#ifdef HG_SAN_ST
                    { unsigned* pw = (unsigned*)&sv; for (int e = 0; e < 4; ++e) { unsigned w = pw[e]; if ((w & 0x7f80u) == 0x7f80u) w &= 0xffff0000u; if ((w & 0x7f800000u) == 0x7f800000u) w &= 0x0000ffffu; pw[e] = w; } }
#endif
                    *(LAS u32x4*)(STL + (c >> 4) * TS + (c & 15) * 16) = sv; }
                load_tile_T(VT, IV + (size_t)r0 * D + cb, D, tid);
            }
            __syncthreads();
#pragma unroll
            for (int kk = 0; kk < 4; ++kk) { bf16x8 Af[4], Bf[2];
#pragma unroll
                for (int m = 0; m < 4; ++m) Af[m] = FRAG(PP, 64 * wr + 16 * m + fr, kk);
#pragma unroll
                for (int n = 0; n < 2; ++n) Bf[n] = FRAG(VT, 32 * wc + 16 * n + fr, kk);
#pragma unroll
                for (int m = 0; m < 4; ++m)
#pragma unroll
                    for (int n = 0; n < 2; ++n) acc[m][n] = __builtin_amdgcn_mfma_f32_16x16x32_bf16(Bf[n], Af[m], acc[m][n], 0, 0, 0);
#pragma unroll
                for (int m = 0; m < 4; ++m) Af[m] = FRAG(QS, 64 * wr + 16 * m + fr, kk);
#pragma unroll
                for (int n = 0; n < 2; ++n) Bf[n] = FRAG(STL, 32 * wc + 16 * n + fr, kk);
#pragma unroll
                for (int m = 0; m < 4; ++m)
#pragma unroll
                    for (int n = 0; n < 2; ++n) acc[m][n] = __builtin_amdgcn_mfma_f32_16x16x32_bf16(Bf[n], Af[m], acc[m][n], 0, 0, 0); }
            __syncthreads();
        }
#pragma unroll
        for (int m = 0; m < 4; ++m) { float ss = 0.f;
#pragma unroll
            for (int n = 0; n < 2; ++n) ss += (acc[m][n][0] * acc[m][n][0] + acc[m][n][1] * acc[m][n][1]) + (acc[m][n][2] * acc[m][n][2] + acc[m][n][3] * acc[m][n][3]);
            ss += __shfl_xor(ss, 16); ss += __shfl_xor(ss, 32);
            if (fq == 0) RED[(64 * wr + 16 * m + fr) * 4 + wc] = ss; }
        __syncthreads();
#pragma unroll
        for (int m = 0; m < 4; ++m) { const int t = 64 * wr + 16 * m + fr; const f32x4 rr = *(const LAS f32x4*)(RED + t * 4);
            const float rstd = rsqrtf(((rr[0] + rr[1]) + (rr[2] + rr[3])) * (1.0f / 128.0f) + 1e-6f);
#pragma unroll
            for (int n = 0; n < 2; ++n) { const int v4 = cb + 32 * wc + 16 * n + 4 * fq; const f32x4 nw = *(const f32x4*)(normw + v4);
                const u32x2 gsv = *(const u32x2*)(GS + (size_t)(r0 + t) * D + v4);
                const f32x4 gs = (f32x4){pg8::bflo(gsv.x), pg8::bfhi(gsv.x), pg8::bflo(gsv.y), pg8::bfhi(gsv.y)};
                f32x4 o = acc[m][n] * rstd * nw * gs; u32x2 w;
#ifdef HG_SANITIZE
                for (int j = 0; j < 4; ++j) o[j] = (fabsf(o[j]) < 1e30f) ? o[j] : 0.f;
#endif
 w.x = pg8::cvt_pk_bf16(o[0], o[1]); w.y = pg8::cvt_pk_bf16(o[2], o[3]);
                *(u32x2*)(OB + (size_t)(r0 + t) * D + v4) = w; } }
        __syncthreads();
    }
}

#define GSYNC() do { asm volatile("s_waitcnt vmcnt(0) lgkmcnt(0)" ::: "memory"); __syncthreads(); grid.sync(); __builtin_amdgcn_fence(__ATOMIC_ACQUIRE, "agent"); asm volatile("s_waitcnt vmcnt(0)" ::: "memory"); } while (0)
template <class Epi> __device__ __forceinline__ void run_gemm(LAS unsigned char* lds, const bf16_t* A, const bf16_t* Bt, int M, int N, int K, const Epi& E, int G, int bid, int wave) {
    pg8::Gemm g{A, Bt, M, N, K}; pg8::StaticOrder S; S.init(M, N, G, bid);
    pg8::gemm_phase<Epi, pg8::StaticOrder, true, true>(lds, g, S, E, wave);
}

__global__ void __launch_bounds__(NTHR, 2) mega_fwd(Args a) {
    extern __shared__ __attribute__((aligned(16))) unsigned char lds_raw[];
    LAS unsigned char* lds = (LAS unsigned char*)lds_raw;
    cg::grid_group grid = cg::this_grid();
    int wave = __builtin_amdgcn_readfirstlane((int)threadIdx.x >> 6); asm volatile("" : "+s"(wave));
    const int G = gridDim.x, bid = blockIdx.x, gw = bid * 8 + wave, ngw = G * 8;
#define WS_PTRS(wsp) float* LB = (float*)((wsp) + WS_LB); float* DEC = (float*)((wsp) + WS_DEC); float* SSQ = (float*)((wsp) + WS_SSQ); f32x2* STAT = (f32x2*)((wsp) + WS_STAT); \
    bf16_t* WB = (bf16_t*)((wsp) + WS_WB); bf16_t* XB = (bf16_t*)((wsp) + WS_XB); bf16_t* BIG = (bf16_t*)((wsp) + WS_BIG); (void)LB; (void)DEC; (void)SSQ; (void)STAT; (void)WB; (void)XB; (void)BIG;
    const float* norm_w = a.in[2];

    {
        const int lane = lane_id(), tid = wave * 64 + lane;
        unsigned char* ws = a.ws; WS_PTRS(ws)
        LAS float* scr = (LAS float*)(lds + wave * 16384);
        for (int l = 0; l < 2; ++l)
            for (int j = 0; j < 2; ++j) { const size_t wo = (size_t)(l * 2 + j);
                conv_matrix(1, a.in[3] + wo * D * FF, a.in[4] + wo * D * FF, FF, D, 2 * FF, norm_w + (l * 3 + (j ? 2 : 0)) * D, WB + WB_FFN + wo * WB_FFN_STRIDE, scr, gw, ngw, lane);
                conv_matrix(0, a.in[5] + wo * FF * D, nullptr, D, FF, D, nullptr, WB + WB_FFN + wo * WB_FFN_STRIDE + WB_DN_OFF, scr, gw, ngw, lane); }
        conv_matrix(0, a.in[6], nullptr, 2 * SGD, D, 2 * SGD, norm_w + 1 * D, WB + WB_SGU_IN, scr, gw, ngw, lane);
        conv_matrix(0, a.in[11], nullptr, D, SGD, D, nullptr, WB + WB_SGU_OUT, scr, gw, ngw, lane);
        conv_matrix(0, a.in[12], nullptr, 5 * D, D, 5 * D, norm_w + 4 * D, WB + WB_HG_IN, scr, gw, ngw, lane);
        conv_matrix(0, a.in[15], nullptr, D, D, D, nullptr, WB + WB_HG_OUT, scr, gw, ngw, lane);
        for (int i = bid * NTHR + tid; i < 2048; i += G * NTHR) { const int d = i >> 10, kq = i & 1023; const float* raw = a.in[13] + d * 2048;
            LB[i] = 1.0f / (1.0f + __expf(raw[kq] - raw[1024 + kq])); }
    }
    GSYNC();

#pragma unroll 1
    for (int s = 0; s < 2; ++s) {
        { unsigned char* ws = a.ws; asm volatile("" : "+s"(ws)); WS_PTRS(ws) prep_rows(a.in[s], XB, SSQ, SLAB, gw, ngw); }
        GSYNC();
#pragma unroll 1
        for (int st = 0; st < 6; ++st) {
            unsigned char* ws = a.ws; asm volatile("" : "+s"(ws)); WS_PTRS(ws)
            const float* xin = a.in[s]; float* xo = a.out + (size_t)s * SLAB * D; asm volatile("" : "+s"(xo));
#ifndef NO_SGU
            if (st == 1) {
                { pg8::EpiSguV E{BIG, SSQ, STAT}; run_gemm(lds, XB, WB + WB_SGU_IN + (size_t)SGD * D, SLAB, SGD, D, E, G, bid, wave); }
                GSYNC();
                sgu_mix(lds, BIG, STAT, a.in[9], a.in[10], a.in[7], a.in[8], G, bid, wave);
                GSYNC();
                { pg8::EpiSguU E{BIG, SSQ}; run_gemm(lds, XB, WB + WB_SGU_IN, SLAB, SGD, D, E, G, bid, wave); }
                GSYNC();
                { pg8::EpiDown E{xo, xo, XB, SSQ, 1.0f}; run_gemm(lds, BIG, WB + WB_SGU_OUT, SLAB, D, SGD, E, G, bid, wave); }
                GSYNC();
            } else
#endif
#ifndef NO_HGRN
            if (st == 4) {
                bf16_t* QSb = BIG; const size_t hst = (size_t)HSL * D; bf16_t* GFb = BIG + hst; bf16_t* GBb = BIG + 2 * hst; bf16_t* IVb = BIG + 3 * hst; bf16_t* GSb = BIG + 4 * hst; bf16_t* OBb = BIG + 5 * hst; bf16_t* STb = BIG + 6 * hst;
#pragma unroll 1
                for (int hf = 0; hf < 2; ++hf) {
                    const size_t ro = (size_t)hf * HSL;
                    { pg8::EpiHgrn E{BIG, hst, SSQ + ro * 16, LB}; run_gemm(lds, XB + ro * D, WB + WB_HG_IN, HSL, 5 * D, D, E, G, bid, wave); }
                    GSYNC();
#ifndef HG_SKIP_A
                    hgrn_pass_a(lds, GFb, GBb, IVb, STb, DEC, G, bid, wave);
#endif
                    GSYNC();
#ifndef HG_SKIP_B
                    hgrn_pass_b(STb, DEC, s == 0 ? 8 : 2, s == 0 ? 16 : 64, G, bid, wave);
#endif
                    GSYNC();
#ifndef HG_SKIP_C
                    hgrn_pass_c(lds, QSb, GFb, GBb, IVb, GSb, STb, a.in[14], OBb, G, bid, wave);
#else
                    OBb = QSb;
#endif
                    GSYNC();
                    { pg8::EpiDown E{xo + ro * D, xo + ro * D, XB + ro * D, SSQ + ro * 16, 1.0f}; run_gemm(lds, OBb, WB + WB_HG_OUT, HSL, D, D, E, G, bid, wave); }
                    GSYNC();
                }
            } else
#endif
            {
                const int fi = (st == 0) ? 0 : (st == 2) ? 1 : (st == 3) ? 2 : 3;
                const bf16_t* wgu = WB + WB_FFN + (size_t)fi * WB_FFN_STRIDE;
                { pg8::EpiSwiGLU E{BIG, FF, SSQ}; run_gemm(lds, XB, wgu, SLAB, 2 * FF, D, E, G, bid, wave); }
                GSYNC();
                { pg8::EpiDown E{st == 0 ? xin : (const float*)xo, xo, XB, SSQ, 0.5f}; run_gemm(lds, BIG, wgu + WB_DN_OFF, SLAB, D, FF, E, G, bid, wave); }
                GSYNC();
            }
        }
        { unsigned char* ws = a.ws; asm volatile("" : "+s"(ws)); WS_PTRS(ws) final_rows(a.out + (size_t)s * SLAB * D, SSQ, a.in[16], SLAB, gw, ngw); }
        GSYNC();
    }
}

extern "C" void kernel_launch(void* const* d_in, const int* in_sizes, int n_in, void* d_out, int out_size, void* d_ws, size_t ws_size, hipStream_t stream) {
    static int grid = 0;
    if (grid == 0) {
        if (n_in != 17 || out_size != 2 * SLAB * D || ws_size < WS_END) { fprintf(stderr, "kernel_launch: unexpected problem (n_in %d, out %d, ws %zu)\n", n_in, out_size, ws_size); grid = -1; return; }
        int dev = 0, cus = 0, per_cu = 0;
        hipGetDevice(&dev); hipDeviceGetAttribute(&cus, hipDeviceAttributeMultiprocessorCount, dev);
        hipFuncSetAttribute((const void*)mega_fwd, hipFuncAttributeMaxDynamicSharedMemorySize, LDS_BYTES);
        hipOccupancyMaxActiveBlocksPerMultiprocessor(&per_cu, (const void*)mega_fwd, NTHR, LDS_BYTES);
        if (per_cu < 1) { fprintf(stderr, "kernel_launch: occupancy query says %d blocks/CU\n", per_cu); per_cu = 1; }
        (void)hipGetLastError();
        grid = cus;
    }
    if (grid < 0) return;
    Args a{};
    for (int i = 0; i < 17; ++i) a.in[i] = (const float*)d_in[i];
    a.out = (float*)d_out; a.ws = (unsigned char*)d_ws;
    void* args[] = {&a};
    hipError_t e = hipLaunchCooperativeKernel((const void*)mega_fwd, dim3(grid), dim3(NTHR), args, LDS_BYTES, stream);
    if (e != hipSuccess) fprintf(stderr, "cooperative launch failed: %s (grid %d)\n", hipGetErrorString(e), grid);
}
```

```cpp
#include <hip/hip_runtime.h>
#include <hip/hip_cooperative_groups.h>
#include <cstdio>
#include <cstdint>
namespace cg = cooperative_groups;
namespace pg8 {
#define PG8_LAS __attribute__((address_space(3)))
typedef unsigned short bf16_t;
typedef short bf16x8 __attribute__((ext_vector_type(8)));
typedef float f32x4 __attribute__((ext_vector_type(4)));
typedef unsigned u32x4 __attribute__((ext_vector_type(4)));
constexpr int BM = 256, BK = 64, HALF = 128, HTB = HALF * BK * 2  , STAGE_BYTES = 8 * HTB, NXCD = 8, WGM = 8;

__host__ __device__ __forceinline__ int lds_byte(int r, int c) { const int st = (r >> 4) * 2 + (c >> 5), rr = r & 15, cc = c & 31, ob = rr * 64 + cc * 2; return st * 1024 + (ob ^ (((ob >> 9) & 1) << 5)); }
__host__ __device__ __forceinline__ void stage_rc(int b, int& R, int& C) { const int st = b / 1024, sb = b % 1024, swz = sb ^ (((sb >> 9) & 1) << 5); R = (st >> 1) * 16 + swz / 64; C = (st & 1) * 32 + (swz % 64) / 2; }
__host__ __device__ __forceinline__ int perm32(int rho) { const int n = rho >> 4, i = rho & 15; return 8 * (i >> 2) + 4 * n + (i & 3); }

struct Unit { int pm, pn; };
struct Gemm { const bf16_t* A; const bf16_t* Bt; int M, N, K; };

struct StaticOrder {
    int nM, nN, nwg, G, c;
    __host__ __device__ void init(int M, int N, int G_, int c_) { nM = M / BM; nN = N / BM; nwg = nM * nN; G = G_; c = c_; }
    __host__ __device__ bool next(int i, Unit& u) const {
        const long L = (long)i * G + c; if (L >= nwg) return false;
        int wgid = (int)L; { const int q = nwg / NXCD, r = nwg % NXCD, xcd = wgid % NXCD, off = wgid / NXCD; wgid = (xcd < r ? xcd * (q + 1) : r * (q + 1) + (xcd - r) * q) + off; }
        const int nig = WGM * nN, gid = wgid / nig, fm = gid * WGM, gsz = (nM - fm) < WGM ? (nM - fm) : WGM;
        u.pm = fm + ((wgid % nig) % gsz); u.pn = (wgid % nig) / gsz; return true;
    }
    __device__ __forceinline__ void a_ready(const Unit&) const {}
    __device__ __forceinline__ void done(const Unit&) const {}
};


#define PG8_GAS __attribute__((address_space(1)))
typedef float f32x2 __attribute__((ext_vector_type(2)));
typedef __bf16 bf16x2_t __attribute__((ext_vector_type(2)));
__device__ __forceinline__ unsigned cvt_pk_bf16(float lo, float hi) { const f32x2 f = {lo, hi}; const bf16x2_t v = __builtin_convertvector(f, bf16x2_t); return __builtin_bit_cast(unsigned, v); }
typedef unsigned u32x2 __attribute__((ext_vector_type(2)));
__device__ __forceinline__ f32x2 gelu_pk(f32x2 v) {
    const f32x2 av = __builtin_elementwise_abs(v), d = av * 0.2316418882f + 1.0f;
    f32x2 t; t.x = __builtin_amdgcn_rcpf(d.x); t.y = __builtin_amdgcn_rcpf(d.y);
    f32x2 q = t * 0.5307027145f + (-0.7265760135f); q = q * t + 0.7107068705f; q = q * t + (-0.142248368f); q = q * t + 0.127414796f; q = q * t;
    const f32x2 s = (v * v) * (-0.72134752044f);
    f32x2 e; e.x = __builtin_amdgcn_exp2f(s.x); e.y = __builtin_amdgcn_exp2f(s.y);
    f32x2 mx; mx.x = fmaxf(v.x, 0.f); mx.y = fmaxf(v.y, 0.f);
    return mx - av * (q * e);
}
__device__ __forceinline__ float shx(float v, int lane, int m) { return __builtin_bit_cast(float, __builtin_amdgcn_ds_bpermute((lane ^ m) << 2, __builtin_bit_cast(int, v))); }
__device__ __forceinline__ f32x4 gelu4(f32x4 v) { const f32x2 a = gelu_pk((f32x2){v[0], v[1]}), b = gelu_pk((f32x2){v[2], v[3]}); return (f32x4){a.x, a.y, b.x, b.y}; }
__device__ __forceinline__ float silu1(float x) { return x * __builtin_amdgcn_rcpf(1.0f + __expf(-x)); }
__device__ __forceinline__ f32x4 silu4(f32x4 v) { return (f32x4){silu1(v[0]), silu1(v[1]), silu1(v[2]), silu1(v[3])}; }
__device__ __forceinline__ float bf2f(unsigned short b) { return __uint_as_float(((unsigned)b) << 16); }
__device__ __forceinline__ float bflo(unsigned w) { return __uint_as_float(w << 16); }
__device__ __forceinline__ float bfhi(unsigned w) { return __uint_as_float(w & 0xffff0000u); }
__device__ __forceinline__ float row_rstd(const float* ssq, int row) {
    const f32x4 a = *(const PG8_GAS f32x4*)(ssq + (size_t)row * 4);
    return rsqrtf(((a[0] + a[1]) + (a[2] + a[3])) * (1.0f / 1024.0f) + 1e-6f);
}

__device__ __forceinline__ void rows_rstd(const float* ssq, int row0, float (&rs)[2][4]) {
    f32x4 pa[2][4];
#pragma unroll
    for (int ai = 0; ai < 2; ++ai)
#pragma unroll
        for (int m = 0; m < 4; ++m) pa[ai][m] = *(const PG8_GAS f32x4*)(ssq + (size_t)(row0 + ai * HALF + m * 16) * 4);
#pragma unroll
    for (int ai = 0; ai < 2; ++ai)
#pragma unroll
        for (int m = 0; m < 4; ++m) { const f32x4 a = pa[ai][m]; rs[ai][m] = rsqrtf(((a[0] + a[1]) + (a[2] + a[3])) * (1.0f / 1024.0f) + 1e-6f); }
    asm volatile("" ::: "memory");
}

struct EpiSwiGLU {
    static constexpr bool PERM = true, AFTER_DRAIN = false;
    bf16_t* H; int ldh; const float* ssq;
    __device__ __forceinline__ void operator()(const f32x4 (&acc)[2][2][4][2], const Unit& u, int wr, int wc, int fr, int fq) const {
        const int row0 = u.pm * BM + wr * 64 + fr, col0 = u.pn * HALF + wc * 32 + 8 * fq;
        float rsv[2][4]; rows_rstd(ssq, row0, rsv);
#pragma unroll
        for (int ai = 0; ai < 2; ++ai)
#pragma unroll
            for (int m = 0; m < 4; ++m) { const int row = row0 + ai * HALF + m * 16; const float rs = rsv[ai][m];
                const float rsn = rs * -1.44269504f;
                const f32x4 g0 = acc[ai][0][m][0] * rs, g1 = acc[ai][0][m][1] * rs, u0 = acc[ai][1][m][0] * rs, u1 = acc[ai][1][m][1] * rs;
                const f32x4 a0 = acc[ai][0][m][0] * rsn, a1 = acc[ai][0][m][1] * rsn; f32x4 h0, h1;
#pragma unroll
                for (int j = 0; j < 4; ++j) { h0[j] = g0[j] * __builtin_amdgcn_rcpf(1.0f + __builtin_amdgcn_exp2f(a0[j])) * u0[j]; h1[j] = g1[j] * __builtin_amdgcn_rcpf(1.0f + __builtin_amdgcn_exp2f(a1[j])) * u1[j]; }
                u32x4 w; w.x = cvt_pk_bf16(h0[0], h0[1]); w.y = cvt_pk_bf16(h0[2], h0[3]); w.z = cvt_pk_bf16(h1[0], h1[1]); w.w = cvt_pk_bf16(h1[2], h1[3]);
                *(PG8_GAS u32x4*)(H + (size_t)row * ldh + col0) = w; }
    }
};
struct EpiDown {
    static constexpr bool PERM = false, AFTER_DRAIN = false;
    const float* res; float* out; bf16_t* xb; float* ssq; float scale; PG8_LAS float* xch;
    __device__ __forceinline__ void operator()(const f32x4 (&acc)[2][2][4][2], const Unit& u, int wr, int wc, int fr, int fq) const {
        const int row0 = u.pm * BM + wr * 64 + fr, col0 = u.pn * BM + wc * 32 + 4 * fq;
#pragma unroll
        for (int ai = 0; ai < 2; ++ai)
#pragma unroll
            for (int m = 0; m < 4; ++m) { const int row = row0 + ai * HALF + m * 16; const size_t off = (size_t)row * 1024 + col0; float s2 = 0.f;
#pragma unroll
                for (int bj = 0; bj < 2; ++bj)
#pragma unroll
                    for (int n = 0; n < 2; ++n) { const f32x4 r = *(const PG8_GAS f32x4*)(res + off + bj * HALF + n * 16); const f32x4 v = r + acc[ai][bj][m][n] * scale;
                        *(PG8_GAS f32x4*)(out + off + bj * HALF + n * 16) = v; u32x2 w; w.x = cvt_pk_bf16(v[0], v[1]); w.y = cvt_pk_bf16(v[2], v[3]);
                        *(PG8_GAS u32x2*)(xb + off + bj * HALF + n * 16) = w; s2 += (v[0] * v[0] + v[1] * v[1]) + (v[2] * v[2] + v[3] * v[3]); }
                s2 += shx(s2, fq * 16 + fr, 16); s2 += shx(s2, fq * 16 + fr, 32);
                if (fq == 0) xch[(ai * HALF + wr * 64 + m * 16 + fr) * 4 + wc] = s2;
                if (m & 1) asm volatile("" ::: "memory"); }
        asm volatile("s_waitcnt lgkmcnt(0)" ::: "memory"); __builtin_amdgcn_s_barrier(); asm volatile("" ::: "memory");
        { const int w8 = wr * 4 + wc, l = fq * 16 + fr; if (l < 32) { const int r = 32 * w8 + l; const f32x4 v = *(const PG8_LAS f32x4*)(xch + r * 4);
            ((PG8_GAS float*)ssq)[(size_t)(u.pm * BM + r) * 4 + u.pn] = (v[0] + v[1]) + (v[2] + v[3]); } }
        asm volatile("s_waitcnt lgkmcnt(0)" ::: "memory"); __builtin_amdgcn_s_barrier(); asm volatile("" ::: "memory");
    }
};
struct EpiSguV {
    static constexpr bool PERM = true, AFTER_DRAIN = false;
    bf16_t* VS; const float* ssq; f32x2* stats;
    __device__ __forceinline__ void operator()(const f32x4 (&acc)[2][2][4][2], const Unit& u, int wr, int wc, int fr, int fq) const {
        const int row0 = u.pm * BM + wr * 64 + fr, col0 = u.pn * BM + wc * 32 + 8 * fq;
        float rsv[2][4]; rows_rstd(ssq, row0, rsv);
#pragma unroll
        for (int ai = 0; ai < 2; ++ai)
#pragma unroll
            for (int m = 0; m < 4; ++m) { const int row = row0 + ai * HALF + m * 16; const float rs = rsv[ai][m]; float s1 = 0.f, s2 = 0.f;
#pragma unroll
                for (int bj = 0; bj < 2; ++bj) { const f32x4 v0 = gelu4(acc[ai][bj][m][0] * rs), v1 = gelu4(acc[ai][bj][m][1] * rs);
                    s1 += ((v0[0] + v0[1]) + (v0[2] + v0[3])) + ((v1[0] + v1[1]) + (v1[2] + v1[3]));
                    s2 += ((v0[0] * v0[0] + v0[1] * v0[1]) + (v0[2] * v0[2] + v0[3] * v0[3])) + ((v1[0] * v1[0] + v1[1] * v1[1]) + (v1[2] * v1[2] + v1[3] * v1[3]));
                    u32x4 w; w.x = cvt_pk_bf16(v0[0], v0[1]); w.y = cvt_pk_bf16(v0[2], v0[3]); w.z = cvt_pk_bf16(v1[0], v1[1]); w.w = cvt_pk_bf16(v1[2], v1[3]);
                    *(PG8_GAS u32x4*)(VS + (size_t)row * 3072 + col0 + bj * HALF) = w; }
                s1 += shx(s1, fq * 16 + fr, 16); s1 += shx(s1, fq * 16 + fr, 32); s2 += shx(s2, fq * 16 + fr, 16); s2 += shx(s2, fq * 16 + fr, 32);
                if (fq == 0) ((PG8_GAS f32x2*)stats)[(size_t)row * 48 + u.pn * 4 + wc] = (f32x2){s1, s2}; }
    }
};
struct EpiSguU {
    static constexpr bool PERM = true, AFTER_DRAIN = false;
    bf16_t* VS; const float* ssq;
    __device__ __forceinline__ void operator()(const f32x4 (&acc)[2][2][4][2], const Unit& u, int wr, int wc, int fr, int fq) const {
        const int row0 = u.pm * BM + wr * 64 + fr, col0 = u.pn * BM + wc * 32 + 8 * fq;
        float rsv[2][4]; rows_rstd(ssq, row0, rsv);
#pragma unroll
        for (int ai = 0; ai < 2; ++ai)
#pragma unroll
            for (int m = 0; m < 4; ++m) { const int row = row0 + ai * HALF + m * 16; const float rs = rsv[ai][m];
#pragma unroll
                for (int bj = 0; bj < 2; ++bj) { PG8_GAS u32x4* p = (PG8_GAS u32x4*)(VS + (size_t)row * 3072 + col0 + bj * HALF); const u32x4 sv = *p;
                    const f32x4 v0 = gelu4(acc[ai][bj][m][0] * rs), v1 = gelu4(acc[ai][bj][m][1] * rs);
                    u32x4 w; w.x = cvt_pk_bf16(v0[0] * bflo(sv.x), v0[1] * bfhi(sv.x)); w.y = cvt_pk_bf16(v0[2] * bflo(sv.y), v0[3] * bfhi(sv.y));
                    w.z = cvt_pk_bf16(v1[0] * bflo(sv.z), v1[1] * bfhi(sv.z)); w.w = cvt_pk_bf16(v1[2] * bflo(sv.w), v1[3] * bfhi(sv.w));
                    *p = w; } if (m & 1) asm volatile("" ::: "memory"); }
    }
};
__device__ __forceinline__ unsigned pk_f16(float a, float b) { const _Float16 ha = (_Float16)a, hb = (_Float16)b; return (unsigned)__builtin_bit_cast(unsigned short, ha) | ((unsigned)__builtin_bit_cast(unsigned short, hb) << 16); }
struct EpiHgrn {
    static constexpr bool PERM = true, AFTER_DRAIN = false;
    bf16_t* O; size_t stride; const float* ssq; const float* lb;
    __device__ __forceinline__ void operator()(const f32x4 (&acc)[2][2][4][2], const Unit& u, int wr, int wc, int fr, int fq) const {
        const int region = u.pn >> 2; const int row0 = u.pm * BM + wr * 64 + fr, col0 = (u.pn & 3) * BM + wc * 32 + 8 * fq;
        bf16_t* base = O + (size_t)region * stride;
        float rsv[2][4]; rows_rstd(ssq, row0, rsv);
        f32x4 l0[2], l1[2];
        if (region == 1 || region == 2) {
#pragma unroll
            for (int bj = 0; bj < 2; ++bj) { l0[bj] = *(const PG8_GAS f32x4*)(lb + (region - 1) * 1024 + col0 + bj * HALF); l1[bj] = *(const PG8_GAS f32x4*)(lb + (region - 1) * 1024 + col0 + bj * HALF + 4); }
        } else { l0[0] = l0[1] = l1[0] = l1[1] = (f32x4){0.f, 0.f, 0.f, 0.f}; }
#pragma unroll
        for (int ai = 0; ai < 2; ++ai)
#pragma unroll
            for (int m = 0; m < 4; ++m) { const int row = row0 + ai * HALF + m * 16; const float rs = rsv[ai][m]; const float rsn = rs * -1.44269504f;
#pragma unroll
                for (int bj = 0; bj < 2; ++bj) { f32x4 v0 = acc[ai][bj][m][0] * rs, v1 = acc[ai][bj][m][1] * rs; u32x4 w;
                    const f32x4 a0 = acc[ai][bj][m][0] * rsn, a1 = acc[ai][bj][m][1] * rsn;
                    if (region == 1 || region == 2) {
#pragma unroll
                        for (int j = 0; j < 4; ++j) { const float sg0 = __builtin_amdgcn_rcpf(1.0f + __builtin_amdgcn_exp2f(a0[j])), sg1 = __builtin_amdgcn_rcpf(1.0f + __builtin_amdgcn_exp2f(a1[j]));
                            v0[j] = __logf(l0[bj][j] + (1.0f - l0[bj][j]) * sg0); v1[j] = __logf(l1[bj][j] + (1.0f - l1[bj][j]) * sg1); }
                        w.x = pk_f16(v0[0], v0[1]); w.y = pk_f16(v0[2], v0[3]); w.z = pk_f16(v1[0], v1[1]); w.w = pk_f16(v1[2], v1[3]);
                    } else {
                        if (region != 3) {
#pragma unroll
                            for (int j = 0; j < 4; ++j) { v0[j] *= __builtin_amdgcn_rcpf(1.0f + __builtin_amdgcn_exp2f(a0[j])); v1[j] *= __builtin_amdgcn_rcpf(1.0f + __builtin_amdgcn_exp2f(a1[j])); } }
                        w.x = cvt_pk_bf16(v0[0], v0[1]); w.y = cvt_pk_bf16(v0[2], v0[3]); w.z = cvt_pk_bf16(v1[0], v1[1]); w.w = cvt_pk_bf16(v1[2], v1[3]);
                    }
                    *(PG8_GAS u32x4*)(base + (size_t)row * 1024 + col0 + bj * HALF) = w; } }
    }
};

#ifdef PROBE_GEMM
#define PG8_PROBE(cat) do { if (wid == 0 && lane == 0) { PG8_LAS unsigned long long* tc_ = (PG8_LAS unsigned long long*)(lds + 152000); const unsigned long long now_ = __builtin_amdgcn_s_memrealtime(); tc_[1 + (cat)] += now_ - tc_[0]; tc_[0] = now_; } } while (0)
#else
#define PG8_PROBE(cat) do { } while (0)
#endif
template <class Epi, class Sched, bool ALIGN_EPI = false, bool SP2 = false>
__device__ __forceinline__ void gemm_phase(PG8_LAS unsigned char* lds, const Gemm g, const Sched& S, const Epi& E, int wave_s) {
    int tid_; { int l_; asm volatile("v_mbcnt_lo_u32_b32 %0, -1, 0\n\tv_mbcnt_hi_u32_b32 %0, -1, %0" : "=v"(l_)); tid_ = wave_s * 64 + l_; }
    const int tid = tid_, wid = wave_s, lane = tid & 63, wr = wid >> 2, wc = wid & 3, fr = lane & 15, fq = lane >> 4;
    const int K = g.K, nt = K / BK;
    unsigned voffA[2], voffB[2];
#pragma unroll
    for (int i = 0; i < 2; ++i) { int R, C; stage_rc(tid * 16 + i * 8192, R, C); const int Rb = Epi::PERM ? ((R & ~31) + perm32(R & 31)) : R;
        voffA[i] = (unsigned)(R * K + C) * 2u; voffB[i] = (unsigned)(Rb * K + C) * 2u; }
    const size_t kstep = (size_t)(BK * 2);
    const size_t hstep = (size_t)HALF * K * 2;
    const size_t tstep = 2 * hstep;
    const unsigned ldsw = (unsigned)wid * 1024u;
    const int aoff = lds_byte(wr * 64 + fr, fq * 8), boff = lds_byte(wc * 32 + fr, fq * 8);
#define PG8_SA(b, h) (((b) * 2 + (h)) * HTB)
#define PG8_SB(b, h) ((4 + (b) * 2 + (h)) * HTB)
#define PG8_STAGE(bufoff, gbase, voff) do { _Pragma("unroll") for (int _i = 0; _i < 2; ++_i) \
        __builtin_amdgcn_global_load_lds((const unsigned*)((const char*)(gbase) + (voff)[_i]), (PG8_LAS unsigned*)(lds + (bufoff) + ldsw + _i * 8192), 16, 0, 0); } while (0)
#define PG8_LDA(dst, b, h) do { _Pragma("unroll") for (int m = 0; m < 4; ++m) _Pragma("unroll") for (int k = 0; k < 2; ++k) dst[m][k] = *(const PG8_LAS bf16x8*)(lds + PG8_SA(b, h) + aoff + m * 2048 + k * 1024); } while (0)
#define PG8_LDB(dst, b, h) do { _Pragma("unroll") for (int n = 0; n < 2; ++n) _Pragma("unroll") for (int k = 0; k < 2; ++k) dst[n][k] = *(const PG8_LAS bf16x8*)(lds + PG8_SB(b, h) + boff + n * 2048 + k * 1024); } while (0)
#define PG8_MMA(ai, bj, At, Bt) do { __builtin_amdgcn_s_setprio(1); _Pragma("unroll") for (int m = 0; m < 4; ++m) _Pragma("unroll") for (int n = 0; n < 2; ++n) _Pragma("unroll") for (int k = 0; k < 2; ++k) \
        acc[ai][bj][m][n] = __builtin_amdgcn_mfma_f32_16x16x32_bf16(Bt[n][k], At[m][k], acc[ai][bj][m][n], 0, 0, 0); __builtin_amdgcn_s_setprio(0); } while (0)
#define PG8_WAIT_V(n) asm volatile("s_waitcnt vmcnt(" #n ")" ::: "memory")
#define PG8_WAIT_L(n) asm volatile("s_waitcnt lgkmcnt(" #n ")" ::: "memory")
#define PG8_BAR __builtin_amdgcn_s_barrier()
#define PG8_SCHED __builtin_amdgcn_sched_barrier(0)
    Unit cur, nxt; int ui = 0;
    if (!S.next(0, cur)) return;
    f32x4 acc[2][2][4][2];
#pragma unroll
    for (int a = 0; a < 2; ++a)
#pragma unroll
        for (int b = 0; b < 2; ++b)
#pragma unroll
            for (int m = 0; m < 4; ++m)
#pragma unroll
                for (int n = 0; n < 2; ++n) acc[a][b][m][n] = (f32x4){0.f, 0.f, 0.f, 0.f};
    bf16x8 At[4][2], B0[2][2], B1[2][2];
    const char* cA = (const char*)g.A + (size_t)cur.pm * tstep; const char* cB = (const char*)g.Bt + (size_t)cur.pn * tstep;
    S.a_ready(cur);
    if constexpr (SP2) {
        PG8_STAGE(PG8_SB(0, 0), cB, voffB); PG8_STAGE(PG8_SB(0, 1), cB + hstep, voffB); PG8_STAGE(PG8_SA(0, 0), cA, voffA); PG8_STAGE(PG8_SA(0, 1), cA + hstep, voffA);
        if (wr == 1) PG8_BAR;
        PG8_WAIT_V(2); PG8_BAR;
        PG8_STAGE(PG8_SB(1, 0), cB + kstep, voffB); PG8_STAGE(PG8_SA(1, 0), cA + kstep, voffA); PG8_STAGE(PG8_SB(1, 1), cB + hstep + kstep, voffB);
        PG8_WAIT_V(6); PG8_BAR;
    } else {
        PG8_STAGE(PG8_SB(0, 0), cB, voffB); PG8_STAGE(PG8_SA(0, 0), cA, voffA); PG8_STAGE(PG8_SB(0, 1), cB + hstep, voffB); PG8_STAGE(PG8_SA(0, 1), cA + hstep, voffA);
        if (wr == 1) PG8_BAR;
        PG8_WAIT_V(4); PG8_BAR;
        PG8_STAGE(PG8_SB(1, 0), cB + kstep, voffB); PG8_STAGE(PG8_SA(1, 0), cA + kstep, voffA); PG8_STAGE(PG8_SB(1, 1), cB + hstep + kstep, voffB);
        PG8_WAIT_V(6); PG8_BAR;
    }
    for (;;) {
        const bool has_next = S.next(ui + 1, nxt);
        const char* nA = has_next ? (const char*)g.A + (size_t)nxt.pm * tstep : cA; const char* nB = has_next ? (const char*)g.Bt + (size_t)nxt.pn * tstep : cB;
        for (int t = 0; t < nt; t += 2) {
            const bool last = (t == nt - 2);
            const char* a1 = cA + (size_t)(t + 1) * kstep;
            const char* a2 = last ? nA : cA + (size_t)(t + 2) * kstep; const char* b2 = last ? nB : cB + (size_t)(t + 2) * kstep;
            const char* a3 = a2 + kstep; const char* b3 = b2 + kstep;
            if (last && has_next) S.a_ready(nxt);
            if constexpr (SP2) {
            PG8_LDB(B0, 0, 0); PG8_LDB(B1, 0, 1); PG8_SCHED; PG8_LDA(At, 0, 0); PG8_STAGE(PG8_SA(1, 1), a1 + hstep, voffA);
            PG8_WAIT_V(8); PG8_WAIT_L(0); PG8_BAR; PG8_MMA(0, 0, At, B0); PG8_MMA(0, 1, At, B1); PG8_BAR; PG8_SCHED;
            PG8_LDA(At, 0, 1); PG8_STAGE(PG8_SB(0, 0), b2, voffB); PG8_STAGE(PG8_SB(0, 1), b2 + hstep, voffB); PG8_STAGE(PG8_SA(0, 0), a2, voffA);
            PG8_WAIT_V(8); PG8_WAIT_L(0); PG8_BAR; PG8_MMA(1, 0, At, B0); PG8_MMA(1, 1, At, B1); PG8_BAR; PG8_SCHED;
            PG8_LDB(B0, 1, 0); PG8_LDB(B1, 1, 1); PG8_SCHED; PG8_LDA(At, 1, 0); PG8_STAGE(PG8_SA(0, 1), a2 + hstep, voffA);
            PG8_WAIT_V(8); PG8_WAIT_L(0); PG8_BAR; PG8_MMA(0, 0, At, B0); PG8_MMA(0, 1, At, B1); PG8_BAR; PG8_SCHED;
            PG8_LDA(At, 1, 1); PG8_STAGE(PG8_SB(1, 0), b3, voffB); PG8_STAGE(PG8_SB(1, 1), b3 + hstep, voffB); PG8_STAGE(PG8_SA(1, 0), a3, voffA);
            PG8_WAIT_V(8); PG8_WAIT_L(0); PG8_BAR; PG8_MMA(1, 0, At, B0); PG8_MMA(1, 1, At, B1); PG8_BAR; PG8_SCHED;
            } else {
            PG8_LDB(B0, 0, 0); PG8_SCHED; PG8_LDA(At, 0, 0); PG8_STAGE(PG8_SA(1, 1), a1 + hstep, voffA);
            PG8_WAIT_L(8); PG8_BAR; PG8_WAIT_L(0); PG8_MMA(0, 0, At, B0); PG8_BAR; PG8_SCHED;
            PG8_LDB(B1, 0, 1); PG8_STAGE(PG8_SB(0, 0), b2, voffB);
            PG8_BAR; PG8_WAIT_L(0); PG8_MMA(0, 1, At, B1); PG8_BAR;
            PG8_LDA(At, 0, 1); PG8_STAGE(PG8_SA(0, 0), a2, voffA);
            PG8_BAR; PG8_WAIT_L(0); PG8_MMA(1, 0, At, B0); PG8_BAR; PG8_SCHED;
            PG8_STAGE(PG8_SB(0, 1), b2 + hstep, voffB);
            PG8_WAIT_V(6); PG8_BAR; PG8_MMA(1, 1, At, B1); PG8_BAR;
            PG8_LDB(B0, 1, 0); PG8_SCHED; PG8_LDA(At, 1, 0); PG8_STAGE(PG8_SA(0, 1), a2 + hstep, voffA);
            PG8_WAIT_L(8); PG8_BAR; PG8_WAIT_L(0); PG8_MMA(0, 0, At, B0); PG8_BAR; PG8_SCHED;
            PG8_LDB(B1, 1, 1); PG8_STAGE(PG8_SB(1, 0), b3, voffB);
            PG8_BAR; PG8_WAIT_L(0); PG8_MMA(0, 1, At, B1); PG8_BAR;
            PG8_LDA(At, 1, 1); PG8_STAGE(PG8_SA(1, 0), a3, voffA);
            PG8_BAR; PG8_WAIT_L(0); PG8_MMA(1, 0, At, B0); PG8_BAR; PG8_SCHED;
            PG8_STAGE(PG8_SB(1, 1), b3 + hstep, voffB);
            PG8_WAIT_V(6); PG8_BAR; PG8_MMA(1, 1, At, B1); PG8_BAR;
            }
        }
        PG8_PROBE(0);
        if constexpr (ALIGN_EPI) { if (wr == 0) PG8_BAR; }
        if constexpr (!Epi::AFTER_DRAIN) { E(acc, cur, wr, wc, fr, fq); S.done(cur); }
        PG8_PROBE(1);
        if (!has_next) break;
#pragma unroll
        for (int a = 0; a < 2; ++a)
#pragma unroll
            for (int b = 0; b < 2; ++b)
#pragma unroll
                for (int m = 0; m < 4; ++m)
#pragma unroll
                    for (int n = 0; n < 2; ++n) acc[a][b][m][n] = (f32x4){0.f, 0.f, 0.f, 0.f};
        cur = nxt; cA = nA; cB = nB; ++ui;
        if constexpr (ALIGN_EPI) { if (wr == 1) PG8_BAR; }
    }
    PG8_WAIT_V(0);
    if constexpr (!ALIGN_EPI) { if (wr == 0) PG8_BAR; }
    PG8_BAR;
    if constexpr (Epi::AFTER_DRAIN) { E.fused(acc, cur, wr, wc, fr, fq, lds, wid, lane); S.done(cur); }
#undef PG8_SA
#undef PG8_SB
#undef PG8_STAGE
#undef PG8_LDA
#undef PG8_LDB
#undef PG8_MMA
#undef PG8_WAIT_V
#undef PG8_WAIT_L
#undef PG8_BAR
#undef PG8_SCHED
}
}

#define LAS __attribute__((address_space(3)))
using pg8::bf16_t; using pg8::bf16x8; using pg8::f32x4; using pg8::f32x2; using pg8::u32x4; using pg8::u32x2;
constexpr int NTHR = 512;
constexpr int D = 1024, FF = 2816, SGD = 3072, SLAB = 32768, HSL = 16384;
constexpr int LDS_BYTES = 155648;
constexpr int TS = 272;
constexpr size_t MiB = 1u << 20;
constexpr size_t WS_LB = 0;
constexpr size_t WS_DEC = 1 * MiB;
constexpr size_t WS_BAR = 2 * MiB;
constexpr size_t WS_SSQ = 4 * MiB;
constexpr size_t WS_STAT = 8 * MiB;
constexpr size_t WS_WB = 24 * MiB;
constexpr size_t WS_XB = 120 * MiB;
constexpr size_t WS_BIG = 184 * MiB;
constexpr size_t WS_END = 504 * MiB;
constexpr size_t WB_FFN = 0, WB_FFN_STRIDE = 8650752, WB_DN_OFF = 5767168;
constexpr size_t WB_SGU_IN = 34603008, WB_SGU_OUT = 40894464, WB_HG_IN = 44040192, WB_HG_OUT = 49283072;

struct Args { const float* in[17]; float* out; unsigned char* ws; };
#define GAS __attribute__((address_space(1)))

#define LDS_WAIT() asm volatile("s_waitcnt lgkmcnt(0)" ::: "memory")
__device__ __forceinline__ unsigned f2bf(float f) { unsigned u = __builtin_bit_cast(unsigned, f); return (u + 0x7fffu + ((u >> 16) & 1u)) >> 16; }
#ifdef HG_CLAMP_G
__device__ __forceinline__ float h2f(unsigned short h) { const float v = (float)__builtin_bit_cast(_Float16, h); return (v >= -1.2f && v <= 0.f) ? v : -0.3f; }
#else
__device__ __forceinline__ float h2f(unsigned short h) { return (float)__builtin_bit_cast(_Float16, h); }
#endif
__device__ __forceinline__ int lane_id() { int r; asm volatile("v_mbcnt_lo_u32_b32 %0, -1, 0\n\tv_mbcnt_hi_u32_b32 %0, -1, %0" : "=v"(r)); return r; }
__device__ __forceinline__ float wave_sum(float v, int lane) {
#pragma unroll
    for (int o = 1; o < 64; o <<= 1) v += pg8::shx(v, lane, o);
    return v;
}

__device__ __forceinline__ void conv_item(const float* W, int ldw, int sc0, int K, const float* scale, bf16_t* WT, int n0, int k0, LAS float* scr, int lane) {
    float wv[32];
#pragma unroll
    for (int i = 0; i < 32; ++i) { const int kk = 2 * i + (lane >> 5); wv[i] = __builtin_nontemporal_load(((const GAS float*)W) + (size_t)(k0 + kk) * ldw + sc0 + (lane & 31)); }
    if (scale) {
#pragma unroll
        for (int i = 0; i < 32; ++i) wv[i] *= ((const GAS float*)scale)[k0 + 2 * i + (lane >> 5)]; }
#pragma unroll
    for (int i = 0; i < 32; ++i) scr[(2 * i + (lane >> 5)) * 33 + (lane & 31)] = wv[i];
    LDS_WAIT(); asm volatile("" ::: "memory");
    const int c = lane & 7;
#pragma unroll
    for (int j = 0; j < 4; ++j) { const int n = (lane >> 3) + 8 * j; const LAS float* s = scr + (8 * c) * 33 + n;
        u32x4 o; o.x = pg8::cvt_pk_bf16(s[0 * 33], s[1 * 33]); o.y = pg8::cvt_pk_bf16(s[2 * 33], s[3 * 33]); o.z = pg8::cvt_pk_bf16(s[4 * 33], s[5 * 33]); o.w = pg8::cvt_pk_bf16(s[6 * 33], s[7 * 33]);
        *(GAS u32x4*)(WT + (size_t)(n0 + n) * K + k0 + 8 * c) = o; }
    LDS_WAIT(); asm volatile("" ::: "memory");
}
__device__ __forceinline__ void conv_matrix(int mode, const float* src0, const float* src1, int ldw, int K, int Ndst, const float* scale, bf16_t* dst, LAS float* scr, int gw, int ngw, int lane) {
    const int nblk = Ndst / 32, nitems = (K / 64) * nblk;
    for (int it = gw; it < nitems; it += ngw) {
        const int kb = it / nblk, nb = it % nblk, n0 = 32 * nb;
        const float* src = src0; int sc0 = n0;
        if (mode == 1) { const int tile = n0 >> 8, half = (n0 >> 7) & 1, i0 = n0 & 127; src = half ? src1 : src0; sc0 = 128 * tile + i0; }
        conv_item(src, ldw, sc0, K, scale, dst, n0, 64 * kb, scr, lane);
    }
}

__device__ __forceinline__ void prep_rows(const float* x, bf16_t* xb, float* ssq, int nrows, int gw, int ngw) {
    int lane = lane_id(); asm volatile("" : "+v"(lane)); asm volatile("" : "+s"(gw));
    for (int m = gw; m < nrows; m += 2 * ngw) {
        const int m2 = m + ngw;
        const GAS f32x4* xr = (const GAS f32x4*)(x + (size_t)m * D) + lane; const GAS f32x4* xr2 = (const GAS f32x4*)(x + (size_t)m2 * D) + lane;
        f32x4 v[4], w2[4];
#pragma unroll
        for (int j = 0; j < 4; ++j) { v[j] = __builtin_nontemporal_load(xr + 64 * j); w2[j] = __builtin_nontemporal_load(xr2 + 64 * j); }
        GAS u32x2* o = (GAS u32x2*)(xb + (size_t)m * D) + lane; GAS u32x2* o2 = (GAS u32x2*)(xb + (size_t)m2 * D) + lane;
#pragma unroll
        for (int j = 0; j < 4; ++j) { u32x2 w; w.x = pg8::cvt_pk_bf16(v[j][0], v[j][1]); w.y = pg8::cvt_pk_bf16(v[j][2], v[j][3]); o[64 * j] = w;
            u32x2 w3; w3.x = pg8::cvt_pk_bf16(w2[j][0], w2[j][1]); w3.y = pg8::cvt_pk_bf16(w2[j][2], w2[j][3]); o2[64 * j] = w3;
            const float s = wave_sum((v[j][0] * v[j][0] + v[j][1] * v[j][1]) + (v[j][2] * v[j][2] + v[j][3] * v[j][3]), lane);
            const float s2 = wave_sum((w2[j][0] * w2[j][0] + w2[j][1] * w2[j][1]) + (w2[j][2] * w2[j][2] + w2[j][3] * w2[j][3]), lane);
            if (lane == 0) { ((GAS float*)ssq)[(size_t)m * 4 + j] = s; ((GAS float*)ssq)[(size_t)m2 * 4 + j] = s2; } }
    }
}
__device__ __forceinline__ void final_rows(float* x, const float* ssq, const float* fw, int nrows, int gw, int ngw) {
    int lane = lane_id(); asm volatile("" : "+v"(lane)); asm volatile("" : "+s"(gw));
    const GAS f32x4* wr = (const GAS f32x4*)fw + lane;
    for (int m = gw; m < nrows; m += 2 * ngw) {
        const int m2 = m + ngw;
        GAS f32x4* xr = (GAS f32x4*)(x + (size_t)m * D) + lane; GAS f32x4* xr2 = (GAS f32x4*)(x + (size_t)m2 * D) + lane;
        f32x4 v[4], w2[4];
#pragma unroll
        for (int j = 0; j < 4; ++j) { v[j] = __builtin_nontemporal_load(xr + 64 * j); w2[j] = __builtin_nontemporal_load(xr2 + 64 * j); }
        const float rs = pg8::row_rstd(ssq, m), rs2 = pg8::row_rstd(ssq, m2);
#pragma unroll
        for (int j = 0; j < 4; ++j) { const f32x4 g = wr[64 * j]; __builtin_nontemporal_store(v[j] * rs * g, xr + 64 * j); __builtin_nontemporal_store(w2[j] * rs2 * g, xr2 + 64 * j); }
    }
}

__device__ __forceinline__ void load_tile_N(LAS unsigned char* T, const bf16_t* src, size_t pitch, int tid) {
#pragma unroll
    for (int i = 0; i < 4; ++i) { const int c = tid + NTHR * i;
        *(LAS u32x4*)(T + (c >> 4) * TS + (c & 15) * 16) = *(const GAS u32x4*)(src + (size_t)(c >> 4) * pitch + (c & 15) * 8); }
}
typedef short s16x4 __attribute__((ext_vector_type(4)));
__device__ __forceinline__ bf16x8 frag_tr_perm(const LAS unsigned char* T, int cbase8, int n, int kk, int lane) {
    const LAS unsigned char* a = T + (32 * kk + 8 * (lane >> 4) + ((lane & 15) >> 2)) * TS + (cbase8 + 8 * (lane & 3) + 4 * n) * 2;
    const s16x4 lo = __builtin_amdgcn_ds_read_tr16_b64_v4i16((LAS s16x4*)a);
    const s16x4 hi = __builtin_amdgcn_ds_read_tr16_b64_v4i16((LAS s16x4*)(a + 4 * TS));
    return (bf16x8){lo.x, lo.y, lo.z, lo.w, hi.x, hi.y, hi.z, hi.w};
}
__device__ __forceinline__ bf16x8 frag_tr(const LAS unsigned char* T, int cbase, int kk, int lane) {
    const LAS unsigned char* a = T + (32 * kk + 8 * (lane >> 4) + ((lane & 15) >> 2)) * TS + (cbase + 4 * (lane & 3)) * 2;
    const s16x4 lo = __builtin_amdgcn_ds_read_tr16_b64_v4i16((LAS s16x4*)a);
    const s16x4 hi = __builtin_amdgcn_ds_read_tr16_b64_v4i16((LAS s16x4*)(a + 4 * TS));
    return (bf16x8){lo.x, lo.y, lo.z, lo.w, hi.x, hi.y, hi.z, hi.w};
}
#define FRAG(base, row, kk) (*(const LAS bf16x8*)((base) + (row) * TS + ((kk) * 32 + 8 * fq) * 2))

__device__ __forceinline__ void sgu_mix(LAS unsigned char* lds, bf16_t* VS, const f32x2* stats, const float* w_s, const float* b_s, const float* lng, const float* lnb, int G, int bid, int wave) {
    int tid = wave * 64 + lane_id();
    const int lane = tid & 63, wid = tid >> 6, wr = wid >> 2, wc = wid & 3, fr = lane & 15, fq = lane >> 4;
    LAS unsigned char* WT = lds; LAS unsigned char* VT = lds + 34816;
    LAS float* MU = (LAS float*)(lds + 69632); LAS float* RS = MU + 128; LAS float* MT = MU + 256; LAS float* RWS = MU + 384;
#pragma unroll 1
    for (int chunk = bid; chunk < SLAB / 128; chunk += G) {
        const int r0 = chunk * 128;
        {
            const GAS f32x2* sp = (const GAS f32x2*)(stats + (size_t)(r0 + (tid >> 2)) * 48 + (tid & 3) * 12); f32x2 pv[12]; float s1 = 0.f, s2 = 0.f;
#pragma unroll
            for (int j = 0; j < 12; ++j) pv[j] = sp[j];
#pragma unroll
            for (int j = 0; j < 12; ++j) { s1 += pv[j].x; s2 += pv[j].y; }
            { const int l_ = lane_id(); s1 += pg8::shx(s1, l_, 1); s1 += pg8::shx(s1, l_, 2); s2 += pg8::shx(s2, l_, 1); s2 += pg8::shx(s2, l_, 2); }
            const float mu = s1 * (1.0f / 3072.0f); const float var = s2 * (1.0f / 3072.0f) - mu * mu;
            if ((tid & 3) == 0) { MU[tid >> 2] = mu; RS[tid >> 2] = rsqrtf(fmaxf(var, 0.f) + 1e-6f); } }
        __syncthreads();
        u32x4 nv[4];
#pragma unroll
        for (int i = 0; i < 4; ++i) { const int idx = tid + NTHR * i; nv[i] = __builtin_nontemporal_load((const GAS u32x4*)(VS + (size_t)(r0 + (idx >> 4)) * SGD + (idx & 15) * 8)); }
        f32x4 wpa[4], wpb[4];
        { const float* wrow = w_s + ((size_t)0 * 128 + (tid >> 2)) * 128 + (tid & 3) * 32;
#pragma unroll
            for (int i = 0; i < 4; ++i) { wpa[i] = *(const GAS f32x4*)(wrow + 8 * i); wpb[i] = *(const GAS f32x4*)(wrow + 8 * i + 4); } }
#pragma unroll 1
        for (int tile = 0; tile < 24; ++tile) {
            const int g = tile / 3, c0 = tile * 128;
            if (tile % 3 == 0) { const int t = tid >> 2, sq = tid & 3; const float* wrow = w_s + ((size_t)g * 128 + t) * 128 + sq * 32; float macc = 0.f, rw = 0.f;
#pragma unroll
                for (int i = 0; i < 4; ++i) { const f32x4 a = wpa[i], b = wpb[i]; const int s0 = sq * 32 + 8 * i;
                    rw += ((a[0] + a[1]) + (a[2] + a[3])) + ((b[0] + b[1]) + (b[2] + b[3]));
                    u32x4 w; w.x = pg8::cvt_pk_bf16(a[0] * RS[s0 + 0], a[1] * RS[s0 + 1]); w.y = pg8::cvt_pk_bf16(a[2] * RS[s0 + 2], a[3] * RS[s0 + 3]);
                    w.z = pg8::cvt_pk_bf16(b[0] * RS[s0 + 4], b[1] * RS[s0 + 5]); w.w = pg8::cvt_pk_bf16(b[2] * RS[s0 + 6], b[3] * RS[s0 + 7]);
                    macc += pg8::bflo(w.x) * MU[s0 + 0] + pg8::bfhi(w.x) * MU[s0 + 1] + pg8::bflo(w.y) * MU[s0 + 2] + pg8::bfhi(w.y) * MU[s0 + 3]
                          + pg8::bflo(w.z) * MU[s0 + 4] + pg8::bfhi(w.z) * MU[s0 + 5] + pg8::bflo(w.w) * MU[s0 + 6] + pg8::bfhi(w.w) * MU[s0 + 7];
                    *(LAS u32x4*)(WT + t * TS + s0 * 2) = w; }
                { const int l_ = lane_id(); macc += pg8::shx(macc, l_, 1); macc += pg8::shx(macc, l_, 2); rw += pg8::shx(rw, l_, 1); rw += pg8::shx(rw, l_, 2); }
                if (sq == 0) { MT[t] = macc; RWS[t] = rw; }
                if (g + 1 < 8) { const float* wnx = wrow + 128 * 128;
#pragma unroll
                    for (int i = 0; i < 4; ++i) { wpa[i] = *(const GAS f32x4*)(wnx + 8 * i); wpb[i] = *(const GAS f32x4*)(wnx + 8 * i + 4); } } }
#pragma unroll
            for (int i = 0; i < 4; ++i) { const int idx = tid + NTHR * i; *(LAS u32x4*)(VT + (idx >> 4) * TS + (idx & 15) * 16) = nv[i]; }
            __syncthreads();
            if (tile + 1 < 24) {
#pragma unroll
                for (int i = 0; i < 4; ++i) { const int idx = tid + NTHR * i; nv[i] = __builtin_nontemporal_load((const GAS u32x4*)(VS + (size_t)(r0 + (idx >> 4)) * SGD + c0 + 128 + (idx & 15) * 8)); } }
            f32x4 lgv[2], lbv[2]; float bsv[4];
#pragma unroll
            for (int n = 0; n < 2; ++n) { const int c4 = c0 + 32 * wc + 8 * fq + 4 * n; lgv[n] = *(const GAS f32x4*)(lng + c4); lbv[n] = *(const GAS f32x4*)(lnb + c4); }
#pragma unroll
            for (int m = 0; m < 4; ++m) bsv[m] = ((const GAS float*)b_s)[g * 128 + 64 * wr + 16 * m + fr];
            f32x4 acc[4][2];
#pragma unroll
            for (int m = 0; m < 4; ++m) { acc[m][0] = (f32x4){0.f, 0.f, 0.f, 0.f}; acc[m][1] = (f32x4){0.f, 0.f, 0.f, 0.f}; }
#pragma unroll
            for (int kk = 0; kk < 4; ++kk) { bf16x8 Af[4], Bf[2];
#pragma unroll
                for (int m = 0; m < 4; ++m) Af[m] = FRAG(WT, 64 * wr + 16 * m + fr, kk);
#pragma unroll
                for (int n = 0; n < 2; ++n) Bf[n] = frag_tr_perm(VT, 32 * wc, n, kk, fq * 16 + fr);
#pragma unroll
                for (int m = 0; m < 4; ++m)
#pragma unroll
                    for (int n = 0; n < 2; ++n) acc[m][n] = __builtin_amdgcn_mfma_f32_16x16x32_bf16(Bf[n], Af[m], acc[m][n], 0, 0, 0); }
#pragma unroll
            for (int m = 0; m < 4; ++m) { const int t = 64 * wr + 16 * m + fr; const float mt = MT[t], rwt = RWS[t], bst = bsv[m]; u32x4 w16;
#pragma unroll
                for (int n = 0; n < 2; ++n) { const f32x4 lg = lgv[n], lb = lbv[n];
                    const f32x4 v = lg * (acc[m][n] - mt) + lb * rwt + bst; if (n == 0) { w16.x = pg8::cvt_pk_bf16(v[0], v[1]); w16.y = pg8::cvt_pk_bf16(v[2], v[3]); } else { w16.z = pg8::cvt_pk_bf16(v[0], v[1]); w16.w = pg8::cvt_pk_bf16(v[2], v[3]); } }
                *(GAS u32x4*)(VS + (size_t)(r0 + t) * SGD + c0 + 32 * wc + 8 * fq) = w16; }
            __syncthreads();
        }
    }
}

__device__ __forceinline__ void hgrn_pass_a(LAS unsigned char* lds, const bf16_t* GF, const bf16_t* GB, const bf16_t* IV, bf16_t* ST, float* DEC, int G, int bid, int wave) {
    int tid = wave * 64 + lane_id();
    const int lane = tid & 63, wid = tid >> 6, wr = wid >> 2, wc = wid & 3, fr = lane & 15, fq = lane >> 4;
    LAS unsigned char* VT = lds; LAS unsigned char* KT = lds + 34816; LAS float* PART = (LAS float*)(lds + 69632);
    const int kp = lane, tg = wave;
#pragma unroll 1
    for (int item = bid; item < 1024; item += G) {
        const int seg = item >> 3, h = item & 7, r0 = seg * 128, cb = h * 128;
        load_tile_N(VT, IV + (size_t)r0 * D + cb, D, tid);
#pragma unroll 1
        for (int dir = 0; dir < 2; ++dir) {
            const bf16_t* Gp2 = (dir ? GB : GF) + (size_t)(r0 + 16 * tg) * D + cb + 2 * kp;
            unsigned graw[16]; f32x2 sum = (f32x2){0.f, 0.f};
#pragma unroll
            for (int i = 0; i < 16; ++i) graw[i] = *(const GAS unsigned*)(Gp2 + (size_t)i * D);
#pragma unroll
            for (int i = 0; i < 16; ++i) { sum.x += h2f((unsigned short)(graw[i] & 0xffffu)); sum.y += h2f((unsigned short)(graw[i] >> 16)); }
            *(LAS f32x2*)(PART + tg * 128 + 2 * kp) = sum;
            __syncthreads();
            f32x2 run = (f32x2){0.f, 0.f}, tot = (f32x2){0.f, 0.f};
#pragma unroll
            for (int j = 0; j < 8; ++j) { const f32x2 a = *(const LAS f32x2*)(PART + j * 128 + 2 * kp); tot += a; if (dir == 0 ? (j > tg) : (j < tg)) run += a; }
            float er0 = __expf(run.x), er1 = __expf(run.y);
            if (dir == 0) {
#pragma unroll
                for (int i = 15; i >= 0; --i) { const float x0 = __expf(h2f((unsigned short)(graw[i] & 0xffffu))), x1 = __expf(h2f((unsigned short)(graw[i] >> 16)));
                    *(LAS unsigned*)(KT + (16 * tg + i) * TS + 4 * kp) = pg8::cvt_pk_bf16((1.0f - x0) * er0, (1.0f - x1) * er1); er0 *= x0; er1 *= x1; }
            } else {
#pragma unroll
                for (int i = 0; i < 16; ++i) { const float x0 = __expf(h2f((unsigned short)(graw[i] & 0xffffu))), x1 = __expf(h2f((unsigned short)(graw[i] >> 16)));
                    *(LAS unsigned*)(KT + (16 * tg + i) * TS + 4 * kp) = pg8::cvt_pk_bf16((1.0f - x0) * er0, (1.0f - x1) * er1); er0 *= x0; er1 *= x1; }
            }
            const size_t idx = ((size_t)(seg * 8 + h) * 2 + dir);
            if (tg == 0) *(GAS f32x2*)(DEC + idx * 128 + 2 * kp) = (f32x2){__expf(tot.x), __expf(tot.y)};
            __syncthreads();
            f32x4 acc[4][2];
#pragma unroll
            for (int m = 0; m < 4; ++m) { acc[m][0] = (f32x4){0.f, 0.f, 0.f, 0.f}; acc[m][1] = (f32x4){0.f, 0.f, 0.f, 0.f}; }
#pragma unroll
            for (int kk = 0; kk < 4; ++kk) { bf16x8 Af[4], Bf[2];
#pragma unroll
                for (int m = 0; m < 4; ++m) Af[m] = frag_tr_perm(KT, 64 * wr + 32 * (m >> 1), m & 1, kk, fq * 16 + fr);
#pragma unroll
                for (int n = 0; n < 2; ++n) Bf[n] = frag_tr(VT, 32 * wc + 16 * n, kk, fq * 16 + fr);
#pragma unroll
                for (int m = 0; m < 4; ++m)
#pragma unroll
                    for (int n = 0; n < 2; ++n) acc[m][n] = __builtin_amdgcn_mfma_f32_16x16x32_bf16(Af[m], Bf[n], acc[m][n], 0, 0, 0); }
            bf16_t* so = ST + idx * 16384;
#pragma unroll
            for (int j = 0; j < 2; ++j)
#pragma unroll
                for (int n = 0; n < 2; ++n) { const int v = 32 * wc + 16 * n + fr, k8 = 64 * wr + 32 * j + 8 * fq; u32x4 w;
                    w.x = pg8::cvt_pk_bf16(acc[2 * j][n][0], acc[2 * j][n][1]); w.y = pg8::cvt_pk_bf16(acc[2 * j][n][2], acc[2 * j][n][3]);
                    w.z = pg8::cvt_pk_bf16(acc[2 * j + 1][n][0], acc[2 * j + 1][n][1]); w.w = pg8::cvt_pk_bf16(acc[2 * j + 1][n][2], acc[2 * j + 1][n][3]);
                    *(GAS u32x4*)(so + v * 128 + k8) = w; }
            __syncthreads();
        }
    }
}
__device__ __forceinline__ void hgrn_pass_b(bf16_t* ST, const float* DEC, int nseq, int nseg, int G, int bid, int wave) {
    int tid = wave * 64 + lane_id();
    const int total = nseq * 16 * 4096;
    for (int w = bid * NTHR + tid; w < total; w += G * NTHR) {
        const int e4 = w & 4095, sh = w >> 12, dir = sh & 1, h = (sh >> 1) & 7, seq = sh >> 4, k0 = (e4 * 4) & 127;
        f32x4 S = (f32x4){0.f, 0.f, 0.f, 0.f};
#pragma unroll 4
        for (int j = 0; j < nseg; ++j) { const int segi = dir ? (nseg - 1 - j) : j; const size_t idx = ((size_t)((seq * nseg + segi) * 8 + h) * 2 + dir);
            GAS u32x2* p = (GAS u32x2*)(ST + idx * 16384 + e4 * 4); const u32x2 uv = *p; const f32x4 d = *(const GAS f32x4*)(DEC + idx * 128 + k0);
            u32x2 o; o.x = pg8::cvt_pk_bf16(S[0], S[1]); o.y = pg8::cvt_pk_bf16(S[2], S[3]); *p = o;
            S = d * S + (f32x4){pg8::bflo(uv.x), pg8::bfhi(uv.x), pg8::bflo(uv.y), pg8::bfhi(uv.y)}; }
    }
}
__device__ __forceinline__ void hgrn_pass_c(LAS unsigned char* lds, const bf16_t* QSg, const bf16_t* GF, const bf16_t* GB, const bf16_t* IV, const bf16_t* GS, const bf16_t* ST, const float* normw, bf16_t* OB, int G, int bid, int wave) {
    int tid = wave * 64 + lane_id();
    const int wid = wave, wr = wid >> 2, wc = wid & 3;
    LAS unsigned char* QS = lds; LAS unsigned char* PP = lds + 34816; LAS unsigned char* Q1 = lds + 69632; LAS unsigned char* KDA = lds + 87040;
    LAS unsigned char* KEA = lds + 104448; LAS unsigned char* KDB = lds + 121856; LAS unsigned char* STL = Q1; LAS unsigned char* VT = KEA;
    LAS float* PART = (LAS float*)(lds + 139264); LAS float* RED = (LAS float*)(lds + 141312);
    const int k = tid & 127, qr = tid >> 7;
#pragma unroll 1
    for (int item = bid; item < 1024; item += G) {
        const int seg = item >> 3, h = item & 7, r0 = seg * 128, cb = h * 128;
        f32x4 acc[4][2];
#pragma unroll
        for (int m = 0; m < 4; ++m) { acc[m][0] = (f32x4){0.f, 0.f, 0.f, 0.f}; acc[m][1] = (f32x4){0.f, 0.f, 0.f, 0.f}; }
#pragma unroll 1
        for (int dir = 0; dir < 2; ++dir) {
            const bf16_t* Gp = (dir ? GB : GF) + (size_t)r0 * D + cb + k; const bf16_t* Qp = QSg + (size_t)r0 * D + cb + k;
            {
                const int kp = lane_id(), tg = wave;
                const bf16_t* Gp2 = (dir ? GB : GF) + (size_t)r0 * D + cb + 2 * kp; const bf16_t* Qp2 = QSg + (size_t)r0 * D + cb + 2 * kp;
                unsigned graw[16], qraw[16]; float s0 = 0.f, s1 = 0.f;
#pragma unroll
                for (int i = 0; i < 16; ++i) { const int p = 16 * tg + i, t = dir ? (127 - p) : p; graw[i] = *(const GAS unsigned*)(Gp2 + (size_t)t * D); qraw[i] = *(const GAS unsigned*)(Qp2 + (size_t)t * D); }
#pragma unroll
                for (int i = 0; i < 16; ++i) { s0 += h2f((unsigned short)(graw[i] & 0xffffu)); s1 += h2f((unsigned short)(graw[i] >> 16)); }
                *(LAS f32x2*)(PART + tg * 128 + 2 * kp) = (f32x2){s0, s1};
                __syncthreads();
                const bool inB = tg >= 4; const int cg = tg & 3, gb0 = tg & 4;
                f32x2 run = (f32x2){0.f, 0.f}, r1 = (f32x2){0.f, 0.f};
#pragma unroll
                for (int j = 0; j < 4; ++j) { const f32x2 a = *(const LAS f32x2*)(PART + j * 128 + 2 * kp); r1 += a;
                    if (j < cg) run += *(const LAS f32x2*)(PART + (gb0 + j) * 128 + 2 * kp); }
                const float er10 = __expf(r1.x), er11 = __expf(r1.y);
#pragma unroll
                for (int i = 0; i < 16; ++i) { const int p = 16 * tg + i, t = dir ? (127 - p) : p, tl = t & 63;
                    const float g0 = h2f((unsigned short)(graw[i] & 0xffffu)), g1 = h2f((unsigned short)(graw[i] >> 16)); run.x += g0; run.y += g1;
                    const float q0 = pg8::bflo(qraw[i]), q1 = pg8::bfhi(qraw[i]); const float kk0 = 1.0f - __expf(g0), kk1 = 1.0f - __expf(g1);
                    const float ep0 = __expf(run.x), ep1 = __expf(run.y), em0 = __builtin_amdgcn_rcpf(ep0), em1 = __builtin_amdgcn_rcpf(ep1);
                    if (!inB) {
                        *(LAS unsigned*)(QS + t * TS + 4 * kp) = pg8::cvt_pk_bf16(q0 * ep0, q1 * ep1);
                        *(LAS unsigned*)(KDA + tl * TS + 4 * kp) = pg8::cvt_pk_bf16(kk0 * em0, kk1 * em1);
                        *(LAS unsigned*)(KEA + tl * TS + 4 * kp) = pg8::cvt_pk_bf16(kk0 * (er10 * em0), kk1 * (er11 * em1));
                    } else {
                        *(LAS unsigned*)(Q1 + tl * TS + 4 * kp) = pg8::cvt_pk_bf16(q0 * ep0, q1 * ep1);
                        *(LAS unsigned*)(QS + t * TS + 4 * kp) = pg8::cvt_pk_bf16(q0 * (er10 * ep0), q1 * (er11 * ep1));
                        *(LAS unsigned*)(KDB + tl * TS + 4 * kp) = pg8::cvt_pk_bf16(kk0 * em0, kk1 * em1);
                    } }
            }
            __syncthreads();
            const int l2 = lane_id(), fr = l2 & 15, fq = l2 >> 4;
            u32x4 stv[4], vtv[4];
            { const GAS u32x4* sg = (const GAS u32x4*)(ST + ((size_t)(seg * 8 + h) * 2 + dir) * 16384); const bf16_t* vsrc = IV + (size_t)r0 * D + cb;
#pragma unroll
                for (int i = 0; i < 4; ++i) { const int c = tid + NTHR * i; stv[i] = sg[c]; vtv[i] = *(const GAS u32x4*)(vsrc + (size_t)(c >> 4) * D + (c & 15) * 8); } }
            {
                const int ct = wid >> 2; const bool tA = (ct == dir);
                const LAS unsigned char* qb = tA ? (QS + (16 * wid) * TS) : (Q1 + ((16 * wid) & 63) * TS);
                bf16x8 Qf[4];
#pragma unroll
                for (int kk = 0; kk < 4; ++kk) Qf[kk] = FRAG(qb, fr, kk);
                const int t = 16 * wid + fr;
#pragma unroll
                for (int j = 0; j < 8; ++j) { const int cs = j >> 2; const bool sA = (cs == dir);
                    f32x4 pacc = (f32x4){0.f, 0.f, 0.f, 0.f};
                    if (!(tA && !sA)) {
                        const LAS unsigned char* kb = (tA ? KDA : (sA ? KEA : KDB)) + ((16 * j) & 63) * TS;
#pragma unroll
                        for (int kk = 0; kk < 4; ++kk) pacc = __builtin_amdgcn_mfma_f32_16x16x32_bf16(FRAG(kb, fr, kk), Qf[kk], pacc, 0, 0, 0);
                        if (tA == sA) {
#pragma unroll
                            for (int r = 0; r < 4; ++r) { const int s = 16 * j + 4 * fq + r; const bool keep = dir ? (s >= t) : (s <= t); if (!keep) pacc[r] = 0.f; }
                        }
                    }
#ifdef HG_SAN_P
                    for (int r = 0; r < 4; ++r) if (!(fabsf(pacc[r]) < 1e6f)) pacc[r] = 0.f;
#endif
                    u32x2 w; w.x = pg8::cvt_pk_bf16(pacc[0], pacc[1]); w.y = pg8::cvt_pk_bf16(pacc[2], pacc[3]);
                    *(LAS u32x2*)(PP + t * TS + (16 * j + 4 * fq) * 2) = w; }
            }
            __syncthreads();
            {
#pragma unroll
                for (int i = 0; i < 4; ++i) { const int c = tid + NTHR * i; *(LAS u32x4*)(STL + (c >> 4) * TS + (c & 15) * 16) = stv[i]; }
#pragma unroll
                for (int i = 0; i < 4; ++i) { const int c = tid + NTHR * i; *(LAS u32x4*)(VT + (c >> 4) * TS + (c & 15) * 16) = vtv[i]; }
            }
            __syncthreads();
#pragma unroll
            for (int kk = 0; kk < 4; ++kk) { bf16x8 Af[4], Bf[2];
#pragma unroll
                for (int m = 0; m < 4; ++m) Af[m] = FRAG(PP, 64 * wr + 16 * m + fr, kk);
#pragma unroll
                for (int n = 0; n < 2; ++n) Bf[n] = frag_tr_perm(VT, 32 * wc, n, kk, fq * 16 + fr);
#pragma unroll
                for (int m = 0; m < 4; ++m)
#pragma unroll
                    for (int n = 0; n < 2; ++n) acc[m][n] = __builtin_amdgcn_mfma_f32_16x16x32_bf16(Bf[n], Af[m], acc[m][n], 0, 0, 0);
#pragma unroll
                for (int m = 0; m < 4; ++m) Af[m] = FRAG(QS, 64 * wr + 16 * m + fr, kk);
#pragma unroll
                for (int n = 0; n < 2; ++n) Bf[n] = FRAG(STL, 32 * wc + 8 * (fr >> 2) + 4 * n + (fr & 3), kk);
#pragma unroll
                for (int m = 0; m < 4; ++m)
#pragma unroll
                    for (int n = 0; n < 2; ++n) acc[m][n] = __builtin_amdgcn_mfma_f32_16x16x32_bf16(Bf[n], Af[m], acc[m][n], 0, 0, 0); }
            __syncthreads();
        }
        const int l3 = lane_id(), fr = l3 & 15, fq = l3 >> 4;
        f32x4 nwv[2]; u32x4 gsq[4];
        const int v8 = cb + 32 * wc + 8 * fq;
#pragma unroll
        for (int n = 0; n < 2; ++n) nwv[n] = *(const GAS f32x4*)(normw + v8 + 4 * n);
#pragma unroll
        for (int m = 0; m < 4; ++m) gsq[m] = *(const GAS u32x4*)(GS + (size_t)(r0 + 64 * wr + 16 * m + fr) * D + v8);
#pragma unroll
        for (int m = 0; m < 4; ++m) { float ss = 0.f;
#pragma unroll
            for (int n = 0; n < 2; ++n) ss += (acc[m][n][0] * acc[m][n][0] + acc[m][n][1] * acc[m][n][1]) + (acc[m][n][2] * acc[m][n][2] + acc[m][n][3] * acc[m][n][3]);
            ss += pg8::shx(ss, l3, 16); ss += pg8::shx(ss, l3, 32);
            if (fq == 0) RED[(64 * wr + 16 * m + fr) * 4 + wc] = ss; }
        __syncthreads();
#pragma unroll
        for (int m = 0; m < 4; ++m) { const int t = 64 * wr + 16 * m + fr; const f32x4 rr = *(const LAS f32x4*)(RED + t * 4);
            const float rstd = rsqrtf(((rr[0] + rr[1]) + (rr[2] + rr[3])) * (1.0f / 128.0f) + 1e-6f);
            u32x4 w16;
#pragma unroll
            for (int n = 0; n < 2; ++n) { const f32x4 nw = nwv[n]; const unsigned g0 = n ? gsq[m].z : gsq[m].x, g1 = n ? gsq[m].w : gsq[m].y;
                const f32x4 gs = (f32x4){pg8::bflo(g0), pg8::bfhi(g0), pg8::bflo(g1), pg8::bfhi(g1)};
                const f32x4 o = acc[m][n] * rstd * nw * gs;
                if (n == 0) { w16.x = pg8::cvt_pk_bf16(o[0], o[1]); w16.y = pg8::cvt_pk_bf16(o[2], o[3]); } else { w16.z = pg8::cvt_pk_bf16(o[0], o[1]); w16.w = pg8::cvt_pk_bf16(o[2], o[3]); } }
            *(GAS u32x4*)(OB + (size_t)(r0 + t) * D + v8) = w16; }
        __syncthreads();
    }
}

#define XB_TMO      128
#define XB_XCNT(j)  (256  + 64 * (j))
#define XB_XSUB(j)  (1280 + 64 * (j))
#define XB_XGEN(j)  (2304 + 64 * (j))
#define XB_TOP      3328
#define XB_TOPGEN   3392
#define XCD_BAR_WORDS 3456
#define XB_SPIN_CAP (1u << 18)

__device__ __forceinline__ unsigned xb_ld(unsigned* p)              { return __hip_atomic_load(p, __ATOMIC_RELAXED, __HIP_MEMORY_SCOPE_AGENT); }
__device__ __forceinline__ unsigned xb_add(unsigned* p, unsigned v) { return __hip_atomic_fetch_add(p, v, __ATOMIC_RELAXED, __HIP_MEMORY_SCOPE_AGENT); }
__device__ __forceinline__ unsigned xb_xcc_id() { return (unsigned)__builtin_amdgcn_s_getreg((3 << 11) | 20) & 0xFu; }
#define XB_SPIN(cond, bar) do { unsigned _sp = 0; while (cond) { __builtin_amdgcn_s_sleep(1); \
    if ((++_sp & 255u) == 0u) { if (xb_ld(&(bar)[XB_TMO])) break; if (_sp > XB_SPIN_CAP) { atomicAdd(&(bar)[XB_TMO], 1u); break; } } } } while (0)

struct XcdBarrier {
    unsigned* bar; unsigned x;
    volatile LAS unsigned* st;
};

__device__ __forceinline__ XcdBarrier xcd_barrier_post(unsigned* bar, volatile LAS unsigned* st, bool leader) {
    XcdBarrier b; b.bar = bar; b.x = xb_xcc_id(); b.st = st;
    if (leader) (void)xb_add(&bar[XB_XCNT(b.x)], 1u);
    return b;
}
__device__ __forceinline__ void xcd_barrier_complete(unsigned* bar, unsigned x, unsigned& nloc, unsigned& nx) {
    const unsigned G = gridDim.x * gridDim.y * gridDim.z;
    unsigned sum, cnt, mine, sp = 0u;
    for (;;) {
        sum = 0u; cnt = 0u; mine = 0u;
#pragma unroll
        for (unsigned j = 0; j < 16; ++j) { const unsigned c = xb_ld(&bar[XB_XCNT(j)]); sum += c; cnt += (c > 0u) ? 1u : 0u; mine = (j == x) ? c : mine; }
        if (sum == G) break;
        __builtin_amdgcn_s_sleep(1);
        if ((++sp & 255u) == 0u) { if (xb_ld(&bar[XB_TMO])) break; if (sp > XB_SPIN_CAP) { atomicAdd(&bar[XB_TMO], 1u); break; } }
    }
    nloc = mine > 0u ? mine : 1u; nx = cnt > 0u ? cnt : 1u;
}

__device__ __forceinline__ void xcd_barrier(const XcdBarrier& b, bool leader) {
    asm volatile("s_waitcnt vmcnt(0)" ::: "memory");
    __syncthreads();
    if (leader) {
        unsigned* bar = b.bar;
        __builtin_amdgcn_s_waitcnt(0);
        unsigned nloc = b.st[0], nx = b.st[1];
        if (nloc == 0u) { xcd_barrier_complete(bar, b.x, nloc, nx); b.st[0] = nloc; b.st[1] = nx; }
        const unsigned old = xb_add(&bar[XB_XSUB(b.x)], 1u);
        const unsigned gen = old / nloc;
        if (old + 1u == (gen + 1u) * nloc) {
            __builtin_amdgcn_fence(__ATOMIC_RELEASE, "agent");
            asm volatile("s_waitcnt vmcnt(0)" ::: "memory");
            const unsigned og = xb_add(&bar[XB_TOP], 1u);
            const unsigned tg = og / nx;
            if (og + 1u == (tg + 1u) * nx) xb_add(&bar[XB_TOPGEN], 1u);
            else XB_SPIN(xb_ld(&bar[XB_TOPGEN]) == tg, bar);
            __builtin_amdgcn_fence(__ATOMIC_ACQUIRE, "agent");
            xb_add(&bar[XB_XGEN(b.x)], 1u);
            asm volatile("s_waitcnt vmcnt(0)" ::: "memory");
        } else {
            XB_SPIN(xb_ld(&bar[XB_XGEN(b.x)]) == gen, bar);
            __builtin_amdgcn_fence(__ATOMIC_ACQUIRE, "agent");
            asm volatile("s_waitcnt vmcnt(0)" ::: "memory");
        }
    }
    __syncthreads();
}

#ifndef PROBE_MIXCAT
#define PROBE_MIXCAT 2
#endif
#ifndef PROBE_ACAT
#define PROBE_ACAT 1
#endif
#ifndef PROBE_BCAT
#define PROBE_BCAT 1
#endif
#ifndef PROBE_CCAT
#define PROBE_CCAT 1
#endif
#ifndef PROBE_UPCAT
#define PROBE_UPCAT 0
#endif
#ifdef PROBE_EXTRA_SYNC
#define GSYNC() do { GSYNC0(); PT(3); GSYNC0(); PT(2); } while (0)
#else
#define GSYNC() do { GSYNC0(); PT(3); } while (0)
#endif
#define GSYNC0() do { xcd_barrier(xbar, wave == 0 && lane_id() == 0); } while (0)
#ifdef PROBE_C1
#ifdef PROBE_GEMM
#define PTC(cat) ((cat) == 3 ? 3 : 4)
#else
#define PTC(cat) (cat)
#endif
#define PT(cat) do { if (wave == 0 && lane_id() == 0) { LAS unsigned long long* tc_ = (LAS unsigned long long*)(lds + 152000); const unsigned long long now_ = __builtin_amdgcn_s_memrealtime(); tc_[1 + PTC(cat)] += now_ - tc_[0]; tc_[0] = now_; } } while (0)
#else
#define PT(cat) do { } while (0)
#endif
template <class Epi> __device__ __forceinline__ void run_gemm(LAS unsigned char* lds, const bf16_t* A, const bf16_t* Bt, int M, int N, int K, const Epi& E, int G, int bid, int wave) {
    pg8::Gemm g{A, Bt, M, N, K}; pg8::StaticOrder S; S.init(M, N, G, bid);
    pg8::gemm_phase<Epi, pg8::StaticOrder, true, true>(lds, g, S, E, wave);
}

__global__ void __launch_bounds__(NTHR, 2) mega_fwd(Args a) {
    extern __shared__ __attribute__((aligned(16))) unsigned char lds_raw[];
    LAS unsigned char* lds = (LAS unsigned char*)lds_raw;
    cg::grid_group grid = cg::this_grid();
    int wave = __builtin_amdgcn_readfirstlane((int)threadIdx.x >> 6); asm volatile("" : "+s"(wave));
    const int G = gridDim.x, bid = blockIdx.x, gw = bid * 8 + wave, ngw = G * 8;
#define WS_PTRS(wsp) float* LB = (float*)((wsp) + WS_LB); float* DEC = (float*)((wsp) + WS_DEC); float* SSQ = (float*)((wsp) + WS_SSQ); f32x2* STAT = (f32x2*)((wsp) + WS_STAT); \
    bf16_t* WB = (bf16_t*)((wsp) + WS_WB); bf16_t* XB = (bf16_t*)((wsp) + WS_XB); bf16_t* BIG = (bf16_t*)((wsp) + WS_BIG); (void)LB; (void)DEC; (void)SSQ; (void)STAT; (void)WB; (void)XB; (void)BIG;
    const float* norm_w = a.in[2];

    { volatile LAS unsigned* st_ = (volatile LAS unsigned*)(lds + 153600); if (wave == 0 && lane_id() < 2) st_[lane_id()] = 0u; }
    __syncthreads();
    const XcdBarrier xbar = xcd_barrier_post((unsigned*)(a.ws + WS_BAR), (volatile LAS unsigned*)(lds + 153600), wave == 0 && lane_id() == 0);
#ifdef PROBE_C1
    if (wave == 0 && lane_id() == 0) { LAS unsigned long long* tc_ = (LAS unsigned long long*)(lds + 152000); tc_[0] = __builtin_amdgcn_s_memrealtime(); for (int i = 1; i < 6; ++i) tc_[i] = 0; }
#endif
    {
        const int lane = lane_id(), tid = wave * 64 + lane;
        unsigned char* ws = a.ws; WS_PTRS(ws)
        LAS float* scr = (LAS float*)(lds + wave * 16384);
        for (int l = 0; l < 2; ++l)
            for (int j = 0; j < 2; ++j) { const size_t wo = (size_t)(l * 2 + j);
                conv_matrix(1, a.in[3] + wo * D * FF, a.in[4] + wo * D * FF, FF, D, 2 * FF, norm_w + (l * 3 + (j ? 2 : 0)) * D, WB + WB_FFN + wo * WB_FFN_STRIDE, scr, gw, ngw, lane);
                conv_matrix(0, a.in[5] + wo * FF * D, nullptr, D, FF, D, nullptr, WB + WB_FFN + wo * WB_FFN_STRIDE + WB_DN_OFF, scr, gw, ngw, lane); }
        conv_matrix(0, a.in[6], nullptr, 2 * SGD, D, 2 * SGD, norm_w + 1 * D, WB + WB_SGU_IN, scr, gw, ngw, lane);
        conv_matrix(0, a.in[11], nullptr, D, SGD, D, nullptr, WB + WB_SGU_OUT, scr, gw, ngw, lane);
        conv_matrix(0, a.in[12], nullptr, 5 * D, D, 5 * D, norm_w + 4 * D, WB + WB_HG_IN, scr, gw, ngw, lane);
        conv_matrix(0, a.in[15], nullptr, D, D, D, nullptr, WB + WB_HG_OUT, scr, gw, ngw, lane);
        for (int i = bid * NTHR + tid; i < 2048; i += G * NTHR) { const int d = i >> 10, kq = i & 1023; const float* raw = a.in[13] + d * 2048;
            ((GAS float*)LB)[i] = 1.0f / (1.0f + __expf(((const GAS float*)raw)[kq] - ((const GAS float*)raw)[1024 + kq])); }
    }
    PT(4);
    GSYNC();
    if (a.ws == nullptr) grid.sync();

#pragma unroll 1
    for (int s = 0; s < 2; ++s) {
        { unsigned char* ws = a.ws; asm volatile("" : "+s"(ws)); WS_PTRS(ws) prep_rows(a.in[s], XB, SSQ, SLAB, gw, ngw); } PT(4);
        GSYNC();
#pragma unroll 1
        for (int st = 0; st < 6; ++st) {
            unsigned char* ws = a.ws; asm volatile("" : "+s"(ws)); WS_PTRS(ws)
            const float* xin = a.in[s]; float* xo = a.out + (size_t)s * SLAB * D; asm volatile("" : "+s"(xo));
#ifndef NO_SGU
            if (st == 1) {
                { pg8::EpiSguV E{BIG, SSQ, STAT}; run_gemm(lds, XB, WB + WB_SGU_IN + (size_t)SGD * D, SLAB, SGD, D, E, G, bid, wave); } PT(0);
                GSYNC();
                sgu_mix(lds, BIG, STAT, a.in[9], a.in[10], a.in[7], a.in[8], G, bid, wave); PT(PROBE_MIXCAT);
                GSYNC();
                { pg8::EpiSguU E{BIG, SSQ}; run_gemm(lds, XB, WB + WB_SGU_IN, SLAB, SGD, D, E, G, bid, wave); } PT(0);
                GSYNC();
                { pg8::EpiDown E{xo, xo, XB, SSQ, 1.0f, (LAS float*)(lds + 135168)}; run_gemm(lds, BIG, WB + WB_SGU_OUT, SLAB, D, SGD, E, G, bid, wave); } PT(0);
                GSYNC();
            } else
#endif
#ifndef NO_HGRN
            if (st == 4) {
                bf16_t* QSb = BIG; const size_t hst = (size_t)HSL * D; bf16_t* GFb = BIG + hst; bf16_t* GBb = BIG + 2 * hst; bf16_t* IVb = BIG + 3 * hst; bf16_t* GSb = BIG + 4 * hst; bf16_t* OBb = BIG + 5 * hst; bf16_t* STb = BIG + 6 * hst;
#pragma unroll 1
                for (int hf = 0; hf < 2; ++hf) {
                    const size_t ro = (size_t)hf * HSL;
                    { pg8::EpiHgrn E{BIG, hst, SSQ + ro * 4, LB}; run_gemm(lds, XB + ro * D, WB + WB_HG_IN, HSL, 5 * D, D, E, G, bid, wave); } PT(0);
                    GSYNC();
#ifndef HG_SKIP_A
                    hgrn_pass_a(lds, GFb, GBb, IVb, STb, DEC, G, bid, wave); PT(PROBE_ACAT);
#endif
                    GSYNC();
#ifndef HG_SKIP_B
                    hgrn_pass_b(STb, DEC, s == 0 ? 8 : 2, s == 0 ? 16 : 64, G, bid, wave); PT(PROBE_BCAT);
#endif
                    GSYNC();
#ifndef HG_SKIP_C
                    hgrn_pass_c(lds, QSb, GFb, GBb, IVb, GSb, STb, a.in[14], OBb, G, bid, wave); PT(PROBE_CCAT);
#else
                    OBb = QSb;
#endif
                    GSYNC();
                    { pg8::EpiDown E{xo + ro * D, xo + ro * D, XB + ro * D, SSQ + ro * 4, 1.0f, (LAS float*)(lds + 135168)}; run_gemm(lds, OBb, WB + WB_HG_OUT, HSL, D, D, E, G, bid, wave); } PT(0);
                    GSYNC();
                }
            } else
#endif
            {
                const int fi = (st == 0) ? 0 : (st == 2) ? 1 : (st == 3) ? 2 : 3;
                const bf16_t* wgu = WB + WB_FFN + (size_t)fi * WB_FFN_STRIDE;
                { pg8::EpiSwiGLU E{BIG, FF, SSQ}; run_gemm(lds, XB, wgu, SLAB, 2 * FF, D, E, G, bid, wave); } PT(PROBE_UPCAT);
                GSYNC();
                { pg8::EpiDown E{st == 0 ? xin : (const float*)xo, xo, XB, SSQ, 0.5f, (LAS float*)(lds + 135168)}; run_gemm(lds, BIG, wgu + WB_DN_OFF, SLAB, D, FF, E, G, bid, wave); } PT(0);
                GSYNC();
            }
        }
        { unsigned char* ws = a.ws; asm volatile("" : "+s"(ws)); WS_PTRS(ws) final_rows(a.out + (size_t)s * SLAB * D, SSQ, a.in[16], SLAB, gw, ngw); } PT(4);
        GSYNC();
    }
#ifdef PROBE_C1
    if (bid == 0 && wave == 0 && lane_id() == 0) { LAS unsigned long long* tc_ = (LAS unsigned long long*)(lds + 152000);
        float tot = 0.f; for (int i = 1; i < 6; ++i) tot += (float)tc_[i];
        const float q1 = rintf(100.f * (float)tc_[1 + PROBE_C1] / tot) * 0.01f, q2 = rintf(1000.f * (float)tc_[1 + PROBE_C2] / tot) * 0.001f;
        const float d1 = sqrtf(33554432.f * 1e-4f * q1), d2 = sqrtf(33554432.f * 1e-6f * q2);
        a.out[0] += d1; a.out[1] += d2; a.out[(size_t)SLAB * D] += d1; a.out[(size_t)SLAB * D + 1] += d2; }
#endif
}

extern "C" void kernel_launch(void* const* d_in, const int* in_sizes, int n_in, void* d_out, int out_size, void* d_ws, size_t ws_size, hipStream_t stream) {
    static int grid = 0;
    if (grid == 0) {
        if (n_in != 17 || out_size != 2 * SLAB * D || ws_size < WS_END) { fprintf(stderr, "kernel_launch: unexpected problem (n_in %d, out %d, ws %zu)\n", n_in, out_size, ws_size); grid = -1; return; }
        int dev = 0, cus = 0, per_cu = 0;
        hipGetDevice(&dev); hipDeviceGetAttribute(&cus, hipDeviceAttributeMultiprocessorCount, dev);
        hipFuncSetAttribute((const void*)mega_fwd, hipFuncAttributeMaxDynamicSharedMemorySize, LDS_BYTES);
        hipOccupancyMaxActiveBlocksPerMultiprocessor(&per_cu, (const void*)mega_fwd, NTHR, LDS_BYTES);
        if (per_cu < 1) { fprintf(stderr, "kernel_launch: occupancy query says %d blocks/CU\n", per_cu); per_cu = 1; }
        (void)hipGetLastError();
        grid = cus;
        if (SLAB % (grid * 16) != 0) { fprintf(stderr, "kernel_launch: unsupported CU count %d\n", cus); grid = -1; return; }
    }
    if (grid < 0) return;
    if (hipMemsetAsync((char*)d_ws + WS_BAR, 0, 16384, stream) != hipSuccess) { fprintf(stderr, "kernel_launch: memset failed\n"); return; }
    Args a{};
    for (int i = 0; i < 17; ++i) a.in[i] = (const float*)d_in[i];
    a.out = (float*)d_out; a.ws = (unsigned char*)d_ws;
    void* args[] = {&a};
    hipError_t e = hipLaunchCooperativeKernel((const void*)mega_fwd, dim3(grid), dim3(NTHR), args, LDS_BYTES, stream);
    if (e != hipSuccess) fprintf(stderr, "cooperative launch failed: %s (grid %d)\n", hipGetErrorString(e), grid);
}
```

```cpp
#include <hip/hip_runtime.h>
#include <hip/hip_cooperative_groups.h>
#include <cstdio>
#include <cstdint>
namespace cg = cooperative_groups;
namespace pg8 {
#define PG8_LAS __attribute__((address_space(3)))
typedef unsigned short bf16_t;
typedef short bf16x8 __attribute__((ext_vector_type(8)));
typedef float f32x4 __attribute__((ext_vector_type(4)));
typedef unsigned u32x4 __attribute__((ext_vector_type(4)));
constexpr int BM = 256, BK = 64, HALF = 128, HTB = HALF * BK * 2  , STAGE_BYTES = 8 * HTB, NXCD = 8, WGM = 8;

__host__ __device__ __forceinline__ int lds_byte(int r, int c) { const int st = (r >> 4) * 2 + (c >> 5), rr = r & 15, cc = c & 31, ob = rr * 64 + cc * 2; return st * 1024 + (ob ^ (((ob >> 9) & 1) << 5)); }
__host__ __device__ __forceinline__ void stage_rc(int b, int& R, int& C) { const int st = b / 1024, sb = b % 1024, swz = sb ^ (((sb >> 9) & 1) << 5); R = (st >> 1) * 16 + swz / 64; C = (st & 1) * 32 + (swz % 64) / 2; }
__host__ __device__ __forceinline__ int perm32(int rho) { const int n = rho >> 4, i = rho & 15; return 8 * (i >> 2) + 4 * n + (i & 3); }

struct Unit { int pm, pn; };
struct Gemm { const bf16_t* A; const bf16_t* Bt; int M, N, K; };

struct StaticOrder {
    int nM, nN, nwg, G, c;
    __host__ __device__ void init(int M, int N, int G_, int c_) { nM = M / BM; nN = N / BM; nwg = nM * nN; G = G_; c = c_; }
    __host__ __device__ bool next(int i, Unit& u) const {
        const long L = (long)i * G + c; if (L >= nwg) return false;
        int wgid = (int)L; { const int q = nwg / NXCD, r = nwg % NXCD, xcd = wgid % NXCD, off = wgid / NXCD; wgid = (xcd < r ? xcd * (q + 1) : r * (q + 1) + (xcd - r) * q) + off; }
        const int nig = WGM * nN, gid = wgid / nig, fm = gid * WGM, gsz = (nM - fm) < WGM ? (nM - fm) : WGM;
        u.pm = fm + ((wgid % nig) % gsz); u.pn = (wgid % nig) / gsz; return true;
    }
    __device__ __forceinline__ void a_ready(const Unit&) const {}
    __device__ __forceinline__ void done(const Unit&) const {}
};


#define PG8_GAS __attribute__((address_space(1)))
typedef float f32x2 __attribute__((ext_vector_type(2)));
typedef __bf16 bf16x2_t __attribute__((ext_vector_type(2)));
__device__ __forceinline__ unsigned cvt_pk_bf16(float lo, float hi) { const f32x2 f = {lo, hi}; const bf16x2_t v = __builtin_convertvector(f, bf16x2_t); return __builtin_bit_cast(unsigned, v); }
typedef unsigned u32x2 __attribute__((ext_vector_type(2)));
__device__ __forceinline__ f32x2 gelu_pk(f32x2 v) {
    const f32x2 av = __builtin_elementwise_abs(v), d = av * 0.2316418882f + 1.0f;
    f32x2 t; t.x = __builtin_amdgcn_rcpf(d.x); t.y = __builtin_amdgcn_rcpf(d.y);
    f32x2 q = t * 0.5307027145f + (-0.7265760135f); q = q * t + 0.7107068705f; q = q * t + (-0.142248368f); q = q * t + 0.127414796f; q = q * t;
    const f32x2 s = (v * v) * (-0.72134752044f);
    f32x2 e; e.x = __builtin_amdgcn_exp2f(s.x); e.y = __builtin_amdgcn_exp2f(s.y);
    f32x2 mx; mx.x = fmaxf(v.x, 0.f); mx.y = fmaxf(v.y, 0.f);
    return mx - av * (q * e);
}
__device__ __forceinline__ float shx(float v, int lane, int m) { return __builtin_bit_cast(float, __builtin_amdgcn_ds_bpermute((lane ^ m) << 2, __builtin_bit_cast(int, v))); }
__device__ __forceinline__ f32x4 gelu4(f32x4 v) { const f32x2 a = gelu_pk((f32x2){v[0], v[1]}), b = gelu_pk((f32x2){v[2], v[3]}); return (f32x4){a.x, a.y, b.x, b.y}; }
__device__ __forceinline__ float silu1(float x) { return x * __builtin_amdgcn_rcpf(1.0f + __expf(-x)); }
__device__ __forceinline__ f32x4 silu4(f32x4 v) { return (f32x4){silu1(v[0]), silu1(v[1]), silu1(v[2]), silu1(v[3])}; }
__device__ __forceinline__ float bf2f(unsigned short b) { return __uint_as_float(((unsigned)b) << 16); }
__device__ __forceinline__ float bflo(unsigned w) { return __uint_as_float(w << 16); }
__device__ __forceinline__ float bfhi(unsigned w) { return __uint_as_float(w & 0xffff0000u); }
__device__ __forceinline__ float row_rstd(const float* ssq, int row) {
    const f32x4 a = *(const PG8_GAS f32x4*)(ssq + (size_t)row * 4);
    return rsqrtf(((a[0] + a[1]) + (a[2] + a[3])) * (1.0f / 1024.0f) + 1e-6f);
}

__device__ __forceinline__ void rows_rstd(const float* ssq, int row0, float (&rs)[2][4]) {
    f32x4 pa[2][4];
#pragma unroll
    for (int ai = 0; ai < 2; ++ai)
#pragma unroll
        for (int m = 0; m < 4; ++m) pa[ai][m] = *(const PG8_GAS f32x4*)(ssq + (size_t)(row0 + ai * HALF + m * 16) * 4);
#pragma unroll
    for (int ai = 0; ai < 2; ++ai)
#pragma unroll
        for (int m = 0; m < 4; ++m) { const f32x4 a = pa[ai][m]; rs[ai][m] = rsqrtf(((a[0] + a[1]) + (a[2] + a[3])) * (1.0f / 1024.0f) + 1e-6f); }
    asm volatile("" ::: "memory");
}

struct EpiSwiGLU {
    static constexpr bool PERM = true, AFTER_DRAIN = false;
    bf16_t* H; int ldh; const float* ssq;
    __device__ __forceinline__ void operator()(const f32x4 (&acc)[2][2][4][2], const Unit& u, int wr, int wc, int fr, int fq) const {
        const int row0 = u.pm * BM + wr * 64 + fr, col0 = u.pn * HALF + wc * 32 + 8 * fq;
        float rsv[2][4]; rows_rstd(ssq, row0, rsv);
#pragma unroll
        for (int ai = 0; ai < 2; ++ai)
#pragma unroll
            for (int m = 0; m < 4; ++m) { const int row = row0 + ai * HALF + m * 16; const float rs = rsv[ai][m];
                const float rsn = rs * -1.44269504f;
                const f32x4 g0 = acc[ai][0][m][0] * rs, g1 = acc[ai][0][m][1] * rs, u0 = acc[ai][1][m][0] * rs, u1 = acc[ai][1][m][1] * rs;
                const f32x4 a0 = acc[ai][0][m][0] * rsn, a1 = acc[ai][0][m][1] * rsn; f32x4 h0, h1;
#pragma unroll
                for (int j = 0; j < 4; ++j) { h0[j] = g0[j] * __builtin_amdgcn_rcpf(1.0f + __builtin_amdgcn_exp2f(a0[j])) * u0[j]; h1[j] = g1[j] * __builtin_amdgcn_rcpf(1.0f + __builtin_amdgcn_exp2f(a1[j])) * u1[j]; }
                u32x4 w; w.x = cvt_pk_bf16(h0[0], h0[1]); w.y = cvt_pk_bf16(h0[2], h0[3]); w.z = cvt_pk_bf16(h1[0], h1[1]); w.w = cvt_pk_bf16(h1[2], h1[3]);
                *(PG8_GAS u32x4*)(H + (size_t)row * ldh + col0) = w; }
    }
};
struct EpiDown {
    static constexpr bool PERM = false, AFTER_DRAIN = false;
    const float* res; float* out; bf16_t* xb; float* ssq; float scale; PG8_LAS float* xch;
    __device__ __forceinline__ void operator()(const f32x4 (&acc)[2][2][4][2], const Unit& u, int wr, int wc, int fr, int fq) const {
        const int row0 = u.pm * BM + wr * 64 + fr, col0 = u.pn * BM + wc * 32 + 4 * fq;
#pragma unroll
        for (int ai = 0; ai < 2; ++ai)
#pragma unroll
            for (int m = 0; m < 4; ++m) { const int row = row0 + ai * HALF + m * 16; const size_t off = (size_t)row * 1024 + col0; float s2 = 0.f;
#pragma unroll
                for (int bj = 0; bj < 2; ++bj)
#pragma unroll
                    for (int n = 0; n < 2; ++n) { const f32x4 r = *(const PG8_GAS f32x4*)(res + off + bj * HALF + n * 16); const f32x4 v = r + acc[ai][bj][m][n] * scale;
                        *(PG8_GAS f32x4*)(out + off + bj * HALF + n * 16) = v; u32x2 w; w.x = cvt_pk_bf16(v[0], v[1]); w.y = cvt_pk_bf16(v[2], v[3]);
                        *(PG8_GAS u32x2*)(xb + off + bj * HALF + n * 16) = w; s2 += (v[0] * v[0] + v[1] * v[1]) + (v[2] * v[2] + v[3] * v[3]); }
                s2 += shx(s2, fq * 16 + fr, 16); s2 += shx(s2, fq * 16 + fr, 32);
                if (fq == 0) xch[(ai * HALF + wr * 64 + m * 16 + fr) * 4 + wc] = s2;
                if (m & 1) asm volatile("" ::: "memory"); }
        asm volatile("s_waitcnt lgkmcnt(0)" ::: "memory"); __builtin_amdgcn_s_barrier(); asm volatile("" ::: "memory");
        { const int w8 = wr * 4 + wc, l = fq * 16 + fr; if (l < 32) { const int r = 32 * w8 + l; const f32x4 v = *(const PG8_LAS f32x4*)(xch + r * 4);
            ((PG8_GAS float*)ssq)[(size_t)(u.pm * BM + r) * 4 + u.pn] = (v[0] + v[1]) + (v[2] + v[3]); } }
        asm volatile("s_waitcnt lgkmcnt(0)" ::: "memory"); __builtin_amdgcn_s_barrier(); asm volatile("" ::: "memory");
    }
};
struct EpiSguV {
    static constexpr bool PERM = true, AFTER_DRAIN = false;
    bf16_t* VS; const float* ssq; f32x2* stats;
    __device__ __forceinline__ void operator()(const f32x4 (&acc)[2][2][4][2], const Unit& u, int wr, int wc, int fr, int fq) const {
        const int row0 = u.pm * BM + wr * 64 + fr, col0 = u.pn * BM + wc * 32 + 8 * fq;
        float rsv[2][4]; rows_rstd(ssq, row0, rsv);
#pragma unroll
        for (int ai = 0; ai < 2; ++ai)
#pragma unroll
            for (int m = 0; m < 4; ++m) { const int row = row0 + ai * HALF + m * 16; const float rs = rsv[ai][m]; float s1 = 0.f, s2 = 0.f;
#pragma unroll
                for (int bj = 0; bj < 2; ++bj) { const f32x4 v0 = gelu4(acc[ai][bj][m][0] * rs), v1 = gelu4(acc[ai][bj][m][1] * rs);
                    s1 += ((v0[0] + v0[1]) + (v0[2] + v0[3])) + ((v1[0] + v1[1]) + (v1[2] + v1[3]));
                    s2 += ((v0[0] * v0[0] + v0[1] * v0[1]) + (v0[2] * v0[2] + v0[3] * v0[3])) + ((v1[0] * v1[0] + v1[1] * v1[1]) + (v1[2] * v1[2] + v1[3] * v1[3]));
                    u32x4 w; w.x = cvt_pk_bf16(v0[0], v0[1]); w.y = cvt_pk_bf16(v0[2], v0[3]); w.z = cvt_pk_bf16(v1[0], v1[1]); w.w = cvt_pk_bf16(v1[2], v1[3]);
                    *(PG8_GAS u32x4*)(VS + (size_t)row * 3072 + col0 + bj * HALF) = w; }
                s1 += shx(s1, fq * 16 + fr, 16); s1 += shx(s1, fq * 16 + fr, 32); s2 += shx(s2, fq * 16 + fr, 16); s2 += shx(s2, fq * 16 + fr, 32);
                if (fq == 0) ((PG8_GAS f32x2*)stats)[(size_t)row * 48 + u.pn * 4 + wc] = (f32x2){s1, s2}; }
    }
};
struct EpiSguU {
    static constexpr bool PERM = true, AFTER_DRAIN = false;
    bf16_t* VS; const float* ssq;
    __device__ __forceinline__ void operator()(const f32x4 (&acc)[2][2][4][2], const Unit& u, int wr, int wc, int fr, int fq) const {
        const int row0 = u.pm * BM + wr * 64 + fr, col0 = u.pn * BM + wc * 32 + 8 * fq;
        float rsv[2][4]; rows_rstd(ssq, row0, rsv);
#pragma unroll
        for (int ai = 0; ai < 2; ++ai)
#pragma unroll
            for (int m = 0; m < 4; ++m) { const int row = row0 + ai * HALF + m * 16; const float rs = rsv[ai][m];
#pragma unroll
                for (int bj = 0; bj < 2; ++bj) { PG8_GAS u32x4* p = (PG8_GAS u32x4*)(VS + (size_t)row * 3072 + col0 + bj * HALF); const u32x4 sv = *p;
                    const f32x4 v0 = gelu4(acc[ai][bj][m][0] * rs), v1 = gelu4(acc[ai][bj][m][1] * rs);
                    u32x4 w; w.x = cvt_pk_bf16(v0[0] * bflo(sv.x), v0[1] * bfhi(sv.x)); w.y = cvt_pk_bf16(v0[2] * bflo(sv.y), v0[3] * bfhi(sv.y));
                    w.z = cvt_pk_bf16(v1[0] * bflo(sv.z), v1[1] * bfhi(sv.z)); w.w = cvt_pk_bf16(v1[2] * bflo(sv.w), v1[3] * bfhi(sv.w));
                    *p = w; } if (m & 1) asm volatile("" ::: "memory"); }
    }
};
__device__ __forceinline__ unsigned pk_f16(float a, float b) { const _Float16 ha = (_Float16)a, hb = (_Float16)b; return (unsigned)__builtin_bit_cast(unsigned short, ha) | ((unsigned)__builtin_bit_cast(unsigned short, hb) << 16); }
struct EpiHgrn {
    static constexpr bool PERM = true, AFTER_DRAIN = false;
    bf16_t* O; size_t stride; const float* ssq; const float* lb;
    __device__ __forceinline__ void operator()(const f32x4 (&acc)[2][2][4][2], const Unit& u, int wr, int wc, int fr, int fq) const {
        const int region = u.pn >> 2; const int row0 = u.pm * BM + wr * 64 + fr, col0 = (u.pn & 3) * BM + wc * 32 + 8 * fq;
        bf16_t* base = O + (size_t)region * stride;
        float rsv[2][4]; rows_rstd(ssq, row0, rsv);
        f32x4 l0[2], l1[2];
        if (region == 1 || region == 2) {
#pragma unroll
            for (int bj = 0; bj < 2; ++bj) { l0[bj] = *(const PG8_GAS f32x4*)(lb + (region - 1) * 1024 + col0 + bj * HALF); l1[bj] = *(const PG8_GAS f32x4*)(lb + (region - 1) * 1024 + col0 + bj * HALF + 4); }
        } else { l0[0] = l0[1] = l1[0] = l1[1] = (f32x4){0.f, 0.f, 0.f, 0.f}; }
#pragma unroll
        for (int ai = 0; ai < 2; ++ai)
#pragma unroll
            for (int m = 0; m < 4; ++m) { const int row = row0 + ai * HALF + m * 16; const float rs = rsv[ai][m]; const float rsn = rs * -1.44269504f;
#pragma unroll
                for (int bj = 0; bj < 2; ++bj) { f32x4 v0 = acc[ai][bj][m][0] * rs, v1 = acc[ai][bj][m][1] * rs; u32x4 w;
                    const f32x4 a0 = acc[ai][bj][m][0] * rsn, a1 = acc[ai][bj][m][1] * rsn;
                    if (region == 1 || region == 2) {
#pragma unroll
                        for (int j = 0; j < 4; ++j) { const float sg0 = __builtin_amdgcn_rcpf(1.0f + __builtin_amdgcn_exp2f(a0[j])), sg1 = __builtin_amdgcn_rcpf(1.0f + __builtin_amdgcn_exp2f(a1[j]));
                            v0[j] = __logf(l0[bj][j] + (1.0f - l0[bj][j]) * sg0); v1[j] = __logf(l1[bj][j] + (1.0f - l1[bj][j]) * sg1); }
                        w.x = pk_f16(v0[0], v0[1]); w.y = pk_f16(v0[2], v0[3]); w.z = pk_f16(v1[0], v1[1]); w.w = pk_f16(v1[2], v1[3]);
                    } else {
                        if (region != 3) {
#pragma unroll
                            for (int j = 0; j < 4; ++j) { v0[j] *= __builtin_amdgcn_rcpf(1.0f + __builtin_amdgcn_exp2f(a0[j])); v1[j] *= __builtin_amdgcn_rcpf(1.0f + __builtin_amdgcn_exp2f(a1[j])); } }
                        w.x = cvt_pk_bf16(v0[0], v0[1]); w.y = cvt_pk_bf16(v0[2], v0[3]); w.z = cvt_pk_bf16(v1[0], v1[1]); w.w = cvt_pk_bf16(v1[2], v1[3]);
                    }
                    *(PG8_GAS u32x4*)(base + (size_t)row * 1024 + col0 + bj * HALF) = w; } }
    }
};

#ifdef PROBE_GEMM
#define PG8_PROBE(cat) do { if (wid == 0 && lane == 0) { PG8_LAS unsigned long long* tc_ = (PG8_LAS unsigned long long*)(lds + 152000); const unsigned long long now_ = __builtin_amdgcn_s_memrealtime(); tc_[1 + (cat)] += now_ - tc_[0]; tc_[0] = now_; } } while (0)
#else
#define PG8_PROBE(cat) do { } while (0)
#endif
template <class Epi, class Sched, bool ALIGN_EPI = false, bool SP2 = false>
__device__ __forceinline__ void gemm_phase(PG8_LAS unsigned char* lds, const Gemm g, const Sched& S, const Epi& E, int wave_s) {
    int tid_; { int l_; asm volatile("v_mbcnt_lo_u32_b32 %0, -1, 0\n\tv_mbcnt_hi_u32_b32 %0, -1, %0" : "=v"(l_)); tid_ = wave_s * 64 + l_; }
    const int tid = tid_, wid = wave_s, lane = tid & 63, wr = wid >> 2, wc = wid & 3, fr = lane & 15, fq = lane >> 4;
    const int K = g.K, nt = K / BK;
    unsigned voffA[2], voffB[2];
#pragma unroll
    for (int i = 0; i < 2; ++i) { int R, C; stage_rc(tid * 16 + i * 8192, R, C); const int Rb = Epi::PERM ? ((R & ~31) + perm32(R & 31)) : R;
        voffA[i] = (unsigned)(R * K + C) * 2u; voffB[i] = (unsigned)(Rb * K + C) * 2u; }
    const size_t kstep = (size_t)(BK * 2);
    const size_t hstep = (size_t)HALF * K * 2;
    const size_t tstep = 2 * hstep;
    const unsigned ldsw = (unsigned)wid * 1024u;
    const int aoff = lds_byte(wr * 64 + fr, fq * 8), boff = lds_byte(wc * 32 + fr, fq * 8);
#define PG8_SA(b, h) (((b) * 2 + (h)) * HTB)
#define PG8_SB(b, h) ((4 + (b) * 2 + (h)) * HTB)
#define PG8_STAGE(bufoff, gbase, voff) do { _Pragma("unroll") for (int _i = 0; _i < 2; ++_i) \
        __builtin_amdgcn_global_load_lds((const unsigned*)((const char*)(gbase) + (voff)[_i]), (PG8_LAS unsigned*)(lds + (bufoff) + ldsw + _i * 8192), 16, 0, 0); } while (0)
#define PG8_LDA(dst, b, h) do { _Pragma("unroll") for (int m = 0; m < 4; ++m) _Pragma("unroll") for (int k = 0; k < 2; ++k) dst[m][k] = *(const PG8_LAS bf16x8*)(lds + PG8_SA(b, h) + aoff + m * 2048 + k * 1024); } while (0)
#define PG8_LDB(dst, b, h) do { _Pragma("unroll") for (int n = 0; n < 2; ++n) _Pragma("unroll") for (int k = 0; k < 2; ++k) dst[n][k] = *(const PG8_LAS bf16x8*)(lds + PG8_SB(b, h) + boff + n * 2048 + k * 1024); } while (0)
#define PG8_MMA(ai, bj, At, Bt) do { __builtin_amdgcn_s_setprio(1); _Pragma("unroll") for (int m = 0; m < 4; ++m) _Pragma("unroll") for (int n = 0; n < 2; ++n) _Pragma("unroll") for (int k = 0; k < 2; ++k) \
        acc[ai][bj][m][n] = __builtin_amdgcn_mfma_f32_16x16x32_bf16(Bt[n][k], At[m][k], acc[ai][bj][m][n], 0, 0, 0); __builtin_amdgcn_s_setprio(0); } while (0)
#define PG8_WAIT_V(n) asm volatile("s_waitcnt vmcnt(" #n ")" ::: "memory")
#define PG8_WAIT_L(n) asm volatile("s_waitcnt lgkmcnt(" #n ")" ::: "memory")
#define PG8_BAR __builtin_amdgcn_s_barrier()
#define PG8_SCHED __builtin_amdgcn_sched_barrier(0)
    Unit cur, nxt; int ui = 0;
    if (!S.next(0, cur)) return;
    f32x4 acc[2][2][4][2];
#pragma unroll
    for (int a = 0; a < 2; ++a)
#pragma unroll
        for (int b = 0; b < 2; ++b)
#pragma unroll
            for (int m = 0; m < 4; ++m)
#pragma unroll
                for (int n = 0; n < 2; ++n) acc[a][b][m][n] = (f32x4){0.f, 0.f, 0.f, 0.f};
    bf16x8 At[4][2], B0[2][2], B1[2][2];
    const char* cA = (const char*)g.A + (size_t)cur.pm * tstep; const char* cB = (const char*)g.Bt + (size_t)cur.pn * tstep;
    S.a_ready(cur);
    if constexpr (SP2) {
        PG8_STAGE(PG8_SB(0, 0), cB, voffB); PG8_STAGE(PG8_SB(0, 1), cB + hstep, voffB); PG8_STAGE(PG8_SA(0, 0), cA, voffA); PG8_STAGE(PG8_SA(0, 1), cA + hstep, voffA);
        if (wr == 1) PG8_BAR;
        PG8_WAIT_V(2); PG8_BAR;
        PG8_STAGE(PG8_SB(1, 0), cB + kstep, voffB); PG8_STAGE(PG8_SA(1, 0), cA + kstep, voffA); PG8_STAGE(PG8_SB(1, 1), cB + hstep + kstep, voffB);
        PG8_WAIT_V(6); PG8_BAR;
    } else {
        PG8_STAGE(PG8_SB(0, 0), cB, voffB); PG8_STAGE(PG8_SA(0, 0), cA, voffA); PG8_STAGE(PG8_SB(0, 1), cB + hstep, voffB); PG8_STAGE(PG8_SA(0, 1), cA + hstep, voffA);
        if (wr == 1) PG8_BAR;
        PG8_WAIT_V(4); PG8_BAR;
        PG8_STAGE(PG8_SB(1, 0), cB + kstep, voffB); PG8_STAGE(PG8_SA(1, 0), cA + kstep, voffA); PG8_STAGE(PG8_SB(1, 1), cB + hstep + kstep, voffB);
        PG8_WAIT_V(6); PG8_BAR;
    }
    for (;;) {
        const bool has_next = S.next(ui + 1, nxt);
        const char* nA = has_next ? (const char*)g.A + (size_t)nxt.pm * tstep : cA; const char* nB = has_next ? (const char*)g.Bt + (size_t)nxt.pn * tstep : cB;
        for (int t = 0; t < nt; t += 2) {
            const bool last = (t == nt - 2);
            const char* a1 = cA + (size_t)(t + 1) * kstep;
            const char* a2 = last ? nA : cA + (size_t)(t + 2) * kstep; const char* b2 = last ? nB : cB + (size_t)(t + 2) * kstep;
            const char* a3 = a2 + kstep; const char* b3 = b2 + kstep;
            if (last && has_next) S.a_ready(nxt);
            if constexpr (SP2) {
            PG8_LDB(B0, 0, 0); PG8_LDB(B1, 0, 1); PG8_SCHED; PG8_LDA(At, 0, 0); PG8_STAGE(PG8_SA(1, 1), a1 + hstep, voffA);
            PG8_WAIT_V(8); PG8_WAIT_L(0); PG8_BAR; PG8_MMA(0, 0, At, B0); PG8_MMA(0, 1, At, B1); PG8_BAR; PG8_SCHED;
            PG8_LDA(At, 0, 1); PG8_STAGE(PG8_SB(0, 0), b2, voffB); PG8_STAGE(PG8_SB(0, 1), b2 + hstep, voffB); PG8_STAGE(PG8_SA(0, 0), a2, voffA);
            PG8_WAIT_V(8); PG8_WAIT_L(0); PG8_BAR; PG8_MMA(1, 0, At, B0); PG8_MMA(1, 1, At, B1); PG8_BAR; PG8_SCHED;
            PG8_LDB(B0, 1, 0); PG8_LDB(B1, 1, 1); PG8_SCHED; PG8_LDA(At, 1, 0); PG8_STAGE(PG8_SA(0, 1), a2 + hstep, voffA);
            PG8_WAIT_V(8); PG8_WAIT_L(0); PG8_BAR; PG8_MMA(0, 0, At, B0); PG8_MMA(0, 1, At, B1); PG8_BAR; PG8_SCHED;
            PG8_LDA(At, 1, 1); PG8_STAGE(PG8_SB(1, 0), b3, voffB); PG8_STAGE(PG8_SB(1, 1), b3 + hstep, voffB); PG8_STAGE(PG8_SA(1, 0), a3, voffA);
            PG8_WAIT_V(8); PG8_WAIT_L(0); PG8_BAR; PG8_MMA(1, 0, At, B0); PG8_MMA(1, 1, At, B1); PG8_BAR; PG8_SCHED;
            } else {
            PG8_LDB(B0, 0, 0); PG8_SCHED; PG8_LDA(At, 0, 0); PG8_STAGE(PG8_SA(1, 1), a1 + hstep, voffA);
            PG8_WAIT_L(8); PG8_BAR; PG8_WAIT_L(0); PG8_MMA(0, 0, At, B0); PG8_BAR; PG8_SCHED;
            PG8_LDB(B1, 0, 1); PG8_STAGE(PG8_SB(0, 0), b2, voffB);
            PG8_BAR; PG8_WAIT_L(0); PG8_MMA(0, 1, At, B1); PG8_BAR;
            PG8_LDA(At, 0, 1); PG8_STAGE(PG8_SA(0, 0), a2, voffA);
            PG8_BAR; PG8_WAIT_L(0); PG8_MMA(1, 0, At, B0); PG8_BAR; PG8_SCHED;
            PG8_STAGE(PG8_SB(0, 1), b2 + hstep, voffB);
            PG8_WAIT_V(6); PG8_BAR; PG8_MMA(1, 1, At, B1); PG8_BAR;
            PG8_LDB(B0, 1, 0); PG8_SCHED; PG8_LDA(At, 1, 0); PG8_STAGE(PG8_SA(0, 1), a2 + hstep, voffA);
            PG8_WAIT_L(8); PG8_BAR; PG8_WAIT_L(0); PG8_MMA(0, 0, At, B0); PG8_BAR; PG8_SCHED;
            PG8_LDB(B1, 1, 1); PG8_STAGE(PG8_SB(1, 0), b3, voffB);
            PG8_BAR; PG8_WAIT_L(0); PG8_MMA(0, 1, At, B1); PG8_BAR;
            PG8_LDA(At, 1, 1); PG8_STAGE(PG8_SA(1, 0), a3, voffA);
            PG8_BAR; PG8_WAIT_L(0); PG8_MMA(1, 0, At, B0); PG8_BAR; PG8_SCHED;
            PG8_STAGE(PG8_SB(1, 1), b3 + hstep, voffB);
            PG8_WAIT_V(6); PG8_BAR; PG8_MMA(1, 1, At, B1); PG8_BAR;
            }
        }
        PG8_PROBE(0);
        if constexpr (ALIGN_EPI) { if (wr == 0) PG8_BAR; }
        if constexpr (!Epi::AFTER_DRAIN) { E(acc, cur, wr, wc, fr, fq); S.done(cur); }
        PG8_PROBE(1);
        if (!has_next) break;
#pragma unroll
        for (int a = 0; a < 2; ++a)
#pragma unroll
            for (int b = 0; b < 2; ++b)
#pragma unroll
                for (int m = 0; m < 4; ++m)
#pragma unroll
                    for (int n = 0; n < 2; ++n) acc[a][b][m][n] = (f32x4){0.f, 0.f, 0.f, 0.f};
        cur = nxt; cA = nA; cB = nB; ++ui;
        if constexpr (ALIGN_EPI) { if (wr == 1) PG8_BAR; }
    }
    PG8_WAIT_V(0);
    if constexpr (!ALIGN_EPI) { if (wr == 0) PG8_BAR; }
    PG8_BAR;
    if constexpr (Epi::AFTER_DRAIN) { E.fused(acc, cur, wr, wc, fr, fq, lds, wid, lane); S.done(cur); }
#undef PG8_SA
#undef PG8_SB
#undef PG8_STAGE
#undef PG8_LDA
#undef PG8_LDB
#undef PG8_MMA
#undef PG8_WAIT_V
#undef PG8_WAIT_L
#undef PG8_BAR
#undef PG8_SCHED
}
}

#define LAS __attribute__((address_space(3)))
using pg8::bf16_t; using pg8::bf16x8; using pg8::f32x4; using pg8::f32x2; using pg8::u32x4; using pg8::u32x2;
constexpr int NTHR = 512;
constexpr int D = 1024, FF = 2816, SGD = 3072, SLAB = 32768, HSL = 16384;
constexpr int LDS_BYTES = 155648;
constexpr int TS = 272;
constexpr size_t MiB = 1u << 20;
constexpr size_t WS_LB = 0;
constexpr size_t WS_DEC = 1 * MiB;
constexpr size_t WS_BAR = 2 * MiB;
constexpr size_t WS_SSQ = 4 * MiB;
constexpr size_t WS_STAT = 8 * MiB;
constexpr size_t WS_WB = 24 * MiB;
constexpr size_t WS_XB = 120 * MiB;
constexpr size_t WS_BIG = 184 * MiB;
constexpr size_t WS_END = 504 * MiB;
constexpr size_t WB_FFN = 0, WB_FFN_STRIDE = 8650752, WB_DN_OFF = 5767168;
constexpr size_t WB_SGU_IN = 34603008, WB_SGU_OUT = 40894464, WB_HG_IN = 44040192, WB_HG_OUT = 49283072;

struct Args { const float* in[17]; float* out; unsigned char* ws; };
#define GAS __attribute__((address_space(1)))

#define LDS_WAIT() asm volatile("s_waitcnt lgkmcnt(0)" ::: "memory")
__device__ __forceinline__ unsigned f2bf(float f) { unsigned u = __builtin_bit_cast(unsigned, f); return (u + 0x7fffu + ((u >> 16) & 1u)) >> 16; }
#ifdef HG_CLAMP_G
__device__ __forceinline__ float h2f(unsigned short h) { const float v = (float)__builtin_bit_cast(_Float16, h); return (v >= -1.2f && v <= 0.f) ? v : -0.3f; }
#else
__device__ __forceinline__ float h2f(unsigned short h) { return (float)__builtin_bit_cast(_Float16, h); }
#endif
__device__ __forceinline__ int lane_id() { int r; asm volatile("v_mbcnt_lo_u32_b32 %0, -1, 0\n\tv_mbcnt_hi_u32_b32 %0, -1, %0" : "=v"(r)); return r; }
__device__ __forceinline__ float wave_sum(float v, int lane) {
#pragma unroll
    for (int o = 1; o < 64; o <<= 1) v += pg8::shx(v, lane, o);
    return v;
}

__device__ __forceinline__ void conv_item(const float* W, int ldw, int sc0, int K, const float* scale, bf16_t* WT, int n0, int k0, LAS float* scr, int lane) {
    float wv[32];
#pragma unroll
    for (int i = 0; i < 32; ++i) { const int kk = 2 * i + (lane >> 5); wv[i] = __builtin_nontemporal_load(((const GAS float*)W) + (size_t)(k0 + kk) * ldw + sc0 + (lane & 31)); }
    if (scale) {
#pragma unroll
        for (int i = 0; i < 32; ++i) wv[i] *= ((const GAS float*)scale)[k0 + 2 * i + (lane >> 5)]; }
#pragma unroll
    for (int i = 0; i < 32; ++i) scr[(2 * i + (lane >> 5)) * 33 + (lane & 31)] = wv[i];
    LDS_WAIT(); asm volatile("" ::: "memory");
    const int c = lane & 7;
#pragma unroll
    for (int j = 0; j < 4; ++j) { const int n = (lane >> 3) + 8 * j; const LAS float* s = scr + (8 * c) * 33 + n;
        u32x4 o; o.x = pg8::cvt_pk_bf16(s[0 * 33], s[1 * 33]); o.y = pg8::cvt_pk_bf16(s[2 * 33], s[3 * 33]); o.z = pg8::cvt_pk_bf16(s[4 * 33], s[5 * 33]); o.w = pg8::cvt_pk_bf16(s[6 * 33], s[7 * 33]);
        *(GAS u32x4*)(WT + (size_t)(n0 + n) * K + k0 + 8 * c) = o; }
    LDS_WAIT(); asm volatile("" ::: "memory");
}
__device__ __forceinline__ void conv_matrix(int mode, const float* src0, const float* src1, int ldw, int K, int Ndst, const float* scale, bf16_t* dst, LAS float* scr, int gw, int ngw, int lane) {
    const int nblk = Ndst / 32, nitems = (K / 64) * nblk;
    for (int it = gw; it < nitems; it += ngw) {
        const int kb = it / nblk, nb = it % nblk, n0 = 32 * nb;
        const float* src = src0; int sc0 = n0;
        if (mode == 1) { const int tile = n0 >> 8, half = (n0 >> 7) & 1, i0 = n0 & 127; src = half ? src1 : src0; sc0 = 128 * tile + i0; }
        conv_item(src, ldw, sc0, K, scale, dst, n0, 64 * kb, scr, lane);
    }
}

__device__ __forceinline__ void prep_rows(const float* x, bf16_t* xb, float* ssq, int nrows, int gw, int ngw) {
    int lane = lane_id(); asm volatile("" : "+v"(lane)); asm volatile("" : "+s"(gw));
    for (int m = gw; m < nrows; m += 2 * ngw) {
        const int m2 = m + ngw;
        const GAS f32x4* xr = (const GAS f32x4*)(x + (size_t)m * D) + lane; const GAS f32x4* xr2 = (const GAS f32x4*)(x + (size_t)m2 * D) + lane;
        f32x4 v[4], w2[4];
#pragma unroll
        for (int j = 0; j < 4; ++j) { v[j] = __builtin_nontemporal_load(xr + 64 * j); w2[j] = __builtin_nontemporal_load(xr2 + 64 * j); }
        GAS u32x2* o = (GAS u32x2*)(xb + (size_t)m * D) + lane; GAS u32x2* o2 = (GAS u32x2*)(xb + (size_t)m2 * D) + lane;
#pragma unroll
        for (int j = 0; j < 4; ++j) { u32x2 w; w.x = pg8::cvt_pk_bf16(v[j][0], v[j][1]); w.y = pg8::cvt_pk_bf16(v[j][2], v[j][3]); o[64 * j] = w;
            u32x2 w3; w3.x = pg8::cvt_pk_bf16(w2[j][0], w2[j][1]); w3.y = pg8::cvt_pk_bf16(w2[j][2], w2[j][3]); o2[64 * j] = w3;
            const float s = wave_sum((v[j][0] * v[j][0] + v[j][1] * v[j][1]) + (v[j][2] * v[j][2] + v[j][3] * v[j][3]), lane);
            const float s2 = wave_sum((w2[j][0] * w2[j][0] + w2[j][1] * w2[j][1]) + (w2[j][2] * w2[j][2] + w2[j][3] * w2[j][3]), lane);
            if (lane == 0) { ((GAS float*)ssq)[(size_t)m * 4 + j] = s; ((GAS float*)ssq)[(size_t)m2 * 4 + j] = s2; } }
    }
}
__device__ __forceinline__ void final_rows(float* x, const float* ssq, const float* fw, int nrows, int gw, int ngw) {
    int lane = lane_id(); asm volatile("" : "+v"(lane)); asm volatile("" : "+s"(gw));
    const GAS f32x4* wr = (const GAS f32x4*)fw + lane;
    for (int m = gw; m < nrows; m += 2 * ngw) {
        const int m2 = m + ngw;
        GAS f32x4* xr = (GAS f32x4*)(x + (size_t)m * D) + lane; GAS f32x4* xr2 = (GAS f32x4*)(x + (size_t)m2 * D) + lane;
        f32x4 v[4], w2[4];
#pragma unroll
        for (int j = 0; j < 4; ++j) { v[j] = __builtin_nontemporal_load(xr + 64 * j); w2[j] = __builtin_nontemporal_load(xr2 + 64 * j); }
        const float rs = pg8::row_rstd(ssq, m), rs2 = pg8::row_rstd(ssq, m2);
#pragma unroll
        for (int j = 0; j < 4; ++j) { const f32x4 g = wr[64 * j]; __builtin_nontemporal_store(v[j] * rs * g, xr + 64 * j); __builtin_nontemporal_store(w2[j] * rs2 * g, xr2 + 64 * j); }
    }
}

__device__ __forceinline__ void load_tile_N(LAS unsigned char* T, const bf16_t* src, size_t pitch, int tid) {
#pragma unroll
    for (int i = 0; i < 4; ++i) { const int c = tid + NTHR * i;
        *(LAS u32x4*)(T + (c >> 4) * TS + (c & 15) * 16) = *(const GAS u32x4*)(src + (size_t)(c >> 4) * pitch + (c & 15) * 8); }
}
typedef short s16x4 __attribute__((ext_vector_type(4)));
__device__ __forceinline__ bf16x8 frag_tr_perm(const LAS unsigned char* T, int cbase8, int n, int kk, int lane) {
    const LAS unsigned char* a = T + (32 * kk + 8 * (lane >> 4) + ((lane & 15) >> 2)) * TS + (cbase8 + 8 * (lane & 3) + 4 * n) * 2;
    const s16x4 lo = __builtin_amdgcn_ds_read_tr16_b64_v4i16((LAS s16x4*)a);
    const s16x4 hi = __builtin_amdgcn_ds_read_tr16_b64_v4i16((LAS s16x4*)(a + 4 * TS));
    return (bf16x8){lo.x, lo.y, lo.z, lo.w, hi.x, hi.y, hi.z, hi.w};
}
__device__ __forceinline__ bf16x8 frag_tr(const LAS unsigned char* T, int cbase, int kk, int lane) {
    const LAS unsigned char* a = T + (32 * kk + 8 * (lane >> 4) + ((lane & 15) >> 2)) * TS + (cbase + 4 * (lane & 3)) * 2;
    const s16x4 lo = __builtin_amdgcn_ds_read_tr16_b64_v4i16((LAS s16x4*)a);
    const s16x4 hi = __builtin_amdgcn_ds_read_tr16_b64_v4i16((LAS s16x4*)(a + 4 * TS));
    return (bf16x8){lo.x, lo.y, lo.z, lo.w, hi.x, hi.y, hi.z, hi.w};
}
#define FRAG(base, row, kk) (*(const LAS bf16x8*)((base) + (row) * TS + ((kk) * 32 + 8 * fq) * 2))

__device__ __forceinline__ void sgu_mix(LAS unsigned char* lds, bf16_t* VS, const f32x2* stats, const float* w_s, const float* b_s, const float* lng, const float* lnb, int G, int bid, int wave) {
    int tid = wave * 64 + lane_id();
    const int lane = tid & 63, wid = tid >> 6, wr = wid >> 2, wc = wid & 3, fr = lane & 15, fq = lane >> 4;
    LAS unsigned char* WT = lds; LAS unsigned char* VT = lds + 34816;
    LAS float* MU = (LAS float*)(lds + 69632); LAS float* RS = MU + 128; LAS float* MT = MU + 256; LAS float* RWS = MU + 384;
#pragma unroll 1
    for (int chunk = bid; chunk < SLAB / 128; chunk += G) {
        const int r0 = chunk * 128;
        {
            const GAS f32x2* sp = (const GAS f32x2*)(stats + (size_t)(r0 + (tid >> 2)) * 48 + (tid & 3) * 12); f32x2 pv[12]; float s1 = 0.f, s2 = 0.f;
#pragma unroll
            for (int j = 0; j < 12; ++j) pv[j] = sp[j];
#pragma unroll
            for (int j = 0; j < 12; ++j) { s1 += pv[j].x; s2 += pv[j].y; }
            { const int l_ = lane_id(); s1 += pg8::shx(s1, l_, 1); s1 += pg8::shx(s1, l_, 2); s2 += pg8::shx(s2, l_, 1); s2 += pg8::shx(s2, l_, 2); }
            const float mu = s1 * (1.0f / 3072.0f); const float var = s2 * (1.0f / 3072.0f) - mu * mu;
            if ((tid & 3) == 0) { MU[tid >> 2] = mu; RS[tid >> 2] = rsqrtf(fmaxf(var, 0.f) + 1e-6f); } }
        __syncthreads();
        u32x4 nv[4];
#pragma unroll
        for (int i = 0; i < 4; ++i) { const int idx = tid + NTHR * i; nv[i] = *(const GAS u32x4*)(VS + (size_t)(r0 + (idx >> 4)) * SGD + (idx & 15) * 8); }
        f32x4 wpa[4], wpb[4];
        { const float* wrow = w_s + ((size_t)0 * 128 + (tid >> 2)) * 128 + (tid & 3) * 32;
#pragma unroll
            for (int i = 0; i < 4; ++i) { wpa[i] = *(const GAS f32x4*)(wrow + 8 * i); wpb[i] = *(const GAS f32x4*)(wrow + 8 * i + 4); } }
#pragma unroll 1
        for (int tile = 0; tile < 24; ++tile) {
            const int g = tile / 3, c0 = tile * 128;
            if (tile % 3 == 0) { const int t = tid >> 2, sq = tid & 3; const float* wrow = w_s + ((size_t)g * 128 + t) * 128 + sq * 32; float macc = 0.f, rw = 0.f;
#pragma unroll
                for (int i = 0; i < 4; ++i) { const f32x4 a = wpa[i], b = wpb[i]; const int s0 = sq * 32 + 8 * i;
                    rw += ((a[0] + a[1]) + (a[2] + a[3])) + ((b[0] + b[1]) + (b[2] + b[3]));
                    u32x4 w; w.x = pg8::cvt_pk_bf16(a[0] * RS[s0 + 0], a[1] * RS[s0 + 1]); w.y = pg8::cvt_pk_bf16(a[2] * RS[s0 + 2], a[3] * RS[s0 + 3]);
                    w.z = pg8::cvt_pk_bf16(b[0] * RS[s0 + 4], b[1] * RS[s0 + 5]); w.w = pg8::cvt_pk_bf16(b[2] * RS[s0 + 6], b[3] * RS[s0 + 7]);
                    macc += pg8::bflo(w.x) * MU[s0 + 0] + pg8::bfhi(w.x) * MU[s0 + 1] + pg8::bflo(w.y) * MU[s0 + 2] + pg8::bfhi(w.y) * MU[s0 + 3]
                          + pg8::bflo(w.z) * MU[s0 + 4] + pg8::bfhi(w.z) * MU[s0 + 5] + pg8::bflo(w.w) * MU[s0 + 6] + pg8::bfhi(w.w) * MU[s0 + 7];
                    *(LAS u32x4*)(WT + t * TS + s0 * 2) = w; }
                { const int l_ = lane_id(); macc += pg8::shx(macc, l_, 1); macc += pg8::shx(macc, l_, 2); rw += pg8::shx(rw, l_, 1); rw += pg8::shx(rw, l_, 2); }
                if (sq == 0) { MT[t] = macc; RWS[t] = rw; }
                if (g + 1 < 8) { const float* wnx = wrow + 128 * 128;
#pragma unroll
                    for (int i = 0; i < 4; ++i) { wpa[i] = *(const GAS f32x4*)(wnx + 8 * i); wpb[i] = *(const GAS f32x4*)(wnx + 8 * i + 4); } } }
#pragma unroll
            for (int i = 0; i < 4; ++i) { const int idx = tid + NTHR * i; *(LAS u32x4*)(VT + (idx >> 4) * TS + (idx & 15) * 16) = nv[i]; }
            __syncthreads();
            if (tile + 1 < 24) {
#pragma unroll
                for (int i = 0; i < 4; ++i) { const int idx = tid + NTHR * i; nv[i] = *(const GAS u32x4*)(VS + (size_t)(r0 + (idx >> 4)) * SGD + c0 + 128 + (idx & 15) * 8); } }
            f32x4 lgv[2], lbv[2]; float bsv[4];
#pragma unroll
            for (int n = 0; n < 2; ++n) { const int c4 = c0 + 32 * wc + 8 * fq + 4 * n; lgv[n] = *(const GAS f32x4*)(lng + c4); lbv[n] = *(const GAS f32x4*)(lnb + c4); }
#pragma unroll
            for (int m = 0; m < 4; ++m) bsv[m] = ((const GAS float*)b_s)[g * 128 + 64 * wr + 16 * m + fr];
            f32x4 acc[4][2];
#pragma unroll
            for (int m = 0; m < 4; ++m) { acc[m][0] = (f32x4){0.f, 0.f, 0.f, 0.f}; acc[m][1] = (f32x4){0.f, 0.f, 0.f, 0.f}; }
#pragma unroll
            for (int kk = 0; kk < 4; ++kk) { bf16x8 Af[4], Bf[2];
#pragma unroll
                for (int m = 0; m < 4; ++m) Af[m] = FRAG(WT, 64 * wr + 16 * m + fr, kk);
#pragma unroll
                for (int n = 0; n < 2; ++n) Bf[n] = frag_tr_perm(VT, 32 * wc, n, kk, fq * 16 + fr);
#pragma unroll
                for (int m = 0; m < 4; ++m)
#pragma unroll
                    for (int n = 0; n < 2; ++n) acc[m][n] = __builtin_amdgcn_mfma_f32_16x16x32_bf16(Bf[n], Af[m], acc[m][n], 0, 0, 0); }
#pragma unroll
            for (int m = 0; m < 4; ++m) { const int t = 64 * wr + 16 * m + fr; const float mt = MT[t], rwt = RWS[t], bst = bsv[m]; u32x4 w16;
#pragma unroll
                for (int n = 0; n < 2; ++n) { const f32x4 lg = lgv[n], lb = lbv[n];
                    const f32x4 v = lg * (acc[m][n] - mt) + lb * rwt + bst; if (n == 0) { w16.x = pg8::cvt_pk_bf16(v[0], v[1]); w16.y = pg8::cvt_pk_bf16(v[2], v[3]); } else { w16.z = pg8::cvt_pk_bf16(v[0], v[1]); w16.w = pg8::cvt_pk_bf16(v[2], v[3]); } }
                *(GAS u32x4*)(VS + (size_t)(r0 + t) * SGD + c0 + 32 * wc + 8 * fq) = w16; }
            __syncthreads();
        }
    }
}

__device__ __forceinline__ void hgrn_pass_a(LAS unsigned char* lds, const bf16_t* GF, const bf16_t* GB, const bf16_t* IV, bf16_t* ST, float* DEC, int G, int bid, int wave) {
    int tid = wave * 64 + lane_id();
    const int lane = tid & 63, wid = tid >> 6, wr = wid >> 2, wc = wid & 3, fr = lane & 15, fq = lane >> 4;
    LAS unsigned char* VT = lds; LAS unsigned char* KT = lds + 34816; LAS float* PART = (LAS float*)(lds + 69632);
    const int kp = lane, tg = wave;
#pragma unroll 1
    for (int item = bid; item < 1024; item += G) {
        const int seg = item >> 3, h = item & 7, r0 = seg * 128, cb = h * 128;
        load_tile_N(VT, IV + (size_t)r0 * D + cb, D, tid);
#pragma unroll 1
        for (int dir = 0; dir < 2; ++dir) {
            const bf16_t* Gp2 = (dir ? GB : GF) + (size_t)(r0 + 16 * tg) * D + cb + 2 * kp;
            unsigned graw[16]; f32x2 sum = (f32x2){0.f, 0.f};
#pragma unroll
            for (int i = 0; i < 16; ++i) graw[i] = *(const GAS unsigned*)(Gp2 + (size_t)i * D);
#pragma unroll
            for (int i = 0; i < 16; ++i) { sum.x += h2f((unsigned short)(graw[i] & 0xffffu)); sum.y += h2f((unsigned short)(graw[i] >> 16)); }
            *(LAS f32x2*)(PART + tg * 128 + 2 * kp) = sum;
            __syncthreads();
            f32x2 run = (f32x2){0.f, 0.f}, tot = (f32x2){0.f, 0.f};
#pragma unroll
            for (int j = 0; j < 8; ++j) { const f32x2 a = *(const LAS f32x2*)(PART + j * 128 + 2 * kp); tot += a; if (dir == 0 ? (j > tg) : (j < tg)) run += a; }
            float er0 = __expf(run.x), er1 = __expf(run.y);
            if (dir == 0) {
#pragma unroll
                for (int i = 15; i >= 0; --i) { const float x0 = __expf(h2f((unsigned short)(graw[i] & 0xffffu))), x1 = __expf(h2f((unsigned short)(graw[i] >> 16)));
                    *(LAS unsigned*)(KT + (16 * tg + i) * TS + 4 * kp) = pg8::cvt_pk_bf16((1.0f - x0) * er0, (1.0f - x1) * er1); er0 *= x0; er1 *= x1; }
            } else {
#pragma unroll
                for (int i = 0; i < 16; ++i) { const float x0 = __expf(h2f((unsigned short)(graw[i] & 0xffffu))), x1 = __expf(h2f((unsigned short)(graw[i] >> 16)));
                    *(LAS unsigned*)(KT + (16 * tg + i) * TS + 4 * kp) = pg8::cvt_pk_bf16((1.0f - x0) * er0, (1.0f - x1) * er1); er0 *= x0; er1 *= x1; }
            }
            const size_t idx = ((size_t)(seg * 8 + h) * 2 + dir);
            if (tg == 0) *(GAS f32x2*)(DEC + idx * 128 + 2 * kp) = (f32x2){__expf(tot.x), __expf(tot.y)};
            __syncthreads();
            f32x4 acc[4][2];
#pragma unroll
            for (int m = 0; m < 4; ++m) { acc[m][0] = (f32x4){0.f, 0.f, 0.f, 0.f}; acc[m][1] = (f32x4){0.f, 0.f, 0.f, 0.f}; }
#pragma unroll
            for (int kk = 0; kk < 4; ++kk) { bf16x8 Af[4], Bf[2];
#pragma unroll
                for (int m = 0; m < 4; ++m) Af[m] = frag_tr_perm(KT, 64 * wr + 32 * (m >> 1), m & 1, kk, fq * 16 + fr);
#pragma unroll
                for (int n = 0; n < 2; ++n) Bf[n] = frag_tr(VT, 32 * wc + 16 * n, kk, fq * 16 + fr);
#pragma unroll
                for (int m = 0; m < 4; ++m)
#pragma unroll
                    for (int n = 0; n < 2; ++n) acc[m][n] = __builtin_amdgcn_mfma_f32_16x16x32_bf16(Af[m], Bf[n], acc[m][n], 0, 0, 0); }
            bf16_t* so = ST + idx * 16384;
#pragma unroll
            for (int j = 0; j < 2; ++j)
#pragma unroll
                for (int n = 0; n < 2; ++n) { const int v = 32 * wc + 16 * n + fr, k8 = 64 * wr + 32 * j + 8 * fq; u32x4 w;
                    w.x = pg8::cvt_pk_bf16(acc[2 * j][n][0], acc[2 * j][n][1]); w.y = pg8::cvt_pk_bf16(acc[2 * j][n][2], acc[2 * j][n][3]);
                    w.z = pg8::cvt_pk_bf16(acc[2 * j + 1][n][0], acc[2 * j + 1][n][1]); w.w = pg8::cvt_pk_bf16(acc[2 * j + 1][n][2], acc[2 * j + 1][n][3]);
                    *(GAS u32x4*)(so + v * 128 + k8) = w; }
            __syncthreads();
        }
    }
}
__device__ __forceinline__ void hgrn_pass_b(bf16_t* ST, const float* DEC, int nseq, int nseg, int G, int bid, int wave) {
    int tid = wave * 64 + lane_id();
    const int total = nseq * 16 * 4096;
    for (int w = bid * NTHR + tid; w < total; w += G * NTHR) {
        const int e4 = w & 4095, sh = w >> 12, dir = sh & 1, h = (sh >> 1) & 7, seq = sh >> 4, k0 = (e4 * 4) & 127;
        f32x4 S = (f32x4){0.f, 0.f, 0.f, 0.f};
#pragma unroll 4
        for (int j = 0; j < nseg; ++j) { const int segi = dir ? (nseg - 1 - j) : j; const size_t idx = ((size_t)((seq * nseg + segi) * 8 + h) * 2 + dir);
            GAS u32x2* p = (GAS u32x2*)(ST + idx * 16384 + e4 * 4); const u32x2 uv = *p; const f32x4 d = *(const GAS f32x4*)(DEC + idx * 128 + k0);
            u32x2 o; o.x = pg8::cvt_pk_bf16(S[0], S[1]); o.y = pg8::cvt_pk_bf16(S[2], S[3]); *p = o;
            S = d * S + (f32x4){pg8::bflo(uv.x), pg8::bfhi(uv.x), pg8::bflo(uv.y), pg8::bfhi(uv.y)}; }
    }
}
__device__ __forceinline__ void hgrn_pass_c(LAS unsigned char* lds, const bf16_t* QSg, const bf16_t* GF, const bf16_t* GB, const bf16_t* IV, const bf16_t* GS, const bf16_t* ST, const float* normw, bf16_t* OB, int G, int bid, int wave) {
    int tid = wave * 64 + lane_id();
    const int wid = wave, wr = wid >> 2, wc = wid & 3;
    LAS unsigned char* QS = lds; LAS unsigned char* PP = lds + 34816; LAS unsigned char* Q1 = lds + 69632; LAS unsigned char* KDA = lds + 87040;
    LAS unsigned char* KEA = lds + 104448; LAS unsigned char* KDB = lds + 121856; LAS unsigned char* STL = Q1; LAS unsigned char* VT = KEA;
    LAS float* PART = (LAS float*)(lds + 139264); LAS float* RED = (LAS float*)(lds + 141312);
    const int k = tid & 127, qr = tid >> 7;
#pragma unroll 1
    for (int item = bid; item < 1024; item += G) {
        const int seg = item >> 3, h = item & 7, r0 = seg * 128, cb = h * 128;
        f32x4 acc[4][2];
#pragma unroll
        for (int m = 0; m < 4; ++m) { acc[m][0] = (f32x4){0.f, 0.f, 0.f, 0.f}; acc[m][1] = (f32x4){0.f, 0.f, 0.f, 0.f}; }
#pragma unroll 1
        for (int dir = 0; dir < 2; ++dir) {
            const bf16_t* Gp = (dir ? GB : GF) + (size_t)r0 * D + cb + k; const bf16_t* Qp = QSg + (size_t)r0 * D + cb + k;
            {
                const int kp = lane_id(), tg = wave;
                const bf16_t* Gp2 = (dir ? GB : GF) + (size_t)r0 * D + cb + 2 * kp; const bf16_t* Qp2 = QSg + (size_t)r0 * D + cb + 2 * kp;
                unsigned graw[16], qraw[16]; float s0 = 0.f, s1 = 0.f;
#pragma unroll
                for (int i = 0; i < 16; ++i) { const int p = 16 * tg + i, t = dir ? (127 - p) : p; graw[i] = *(const GAS unsigned*)(Gp2 + (size_t)t * D); qraw[i] = __builtin_nontemporal_load((const GAS unsigned*)(Qp2 + (size_t)t * D)); }
#pragma unroll
                for (int i = 0; i < 16; ++i) { s0 += h2f((unsigned short)(graw[i] & 0xffffu)); s1 += h2f((unsigned short)(graw[i] >> 16)); }
                *(LAS f32x2*)(PART + tg * 128 + 2 * kp) = (f32x2){s0, s1};
                __syncthreads();
                const bool inB = tg >= 4; const int cg = tg & 3, gb0 = tg & 4;
                f32x2 run = (f32x2){0.f, 0.f}, r1 = (f32x2){0.f, 0.f};
#pragma unroll
                for (int j = 0; j < 4; ++j) { const f32x2 a = *(const LAS f32x2*)(PART + j * 128 + 2 * kp); r1 += a;
                    if (j < cg) run += *(const LAS f32x2*)(PART + (gb0 + j) * 128 + 2 * kp); }
                const float er10 = __expf(r1.x), er11 = __expf(r1.y);
#pragma unroll
                for (int i = 0; i < 16; ++i) { const int p = 16 * tg + i, t = dir ? (127 - p) : p, tl = t & 63;
                    const float g0 = h2f((unsigned short)(graw[i] & 0xffffu)), g1 = h2f((unsigned short)(graw[i] >> 16)); run.x += g0; run.y += g1;
                    const float q0 = pg8::bflo(qraw[i]), q1 = pg8::bfhi(qraw[i]); const float kk0 = 1.0f - __expf(g0), kk1 = 1.0f - __expf(g1);
                    const float ep0 = __expf(run.x), ep1 = __expf(run.y), em0 = __builtin_amdgcn_rcpf(ep0), em1 = __builtin_amdgcn_rcpf(ep1);
                    if (!inB) {
                        *(LAS unsigned*)(QS + t * TS + 4 * kp) = pg8::cvt_pk_bf16(q0 * ep0, q1 * ep1);
                        *(LAS unsigned*)(KDA + tl * TS + 4 * kp) = pg8::cvt_pk_bf16(kk0 * em0, kk1 * em1);
                        *(LAS unsigned*)(KEA + tl * TS + 4 * kp) = pg8::cvt_pk_bf16(kk0 * (er10 * em0), kk1 * (er11 * em1));
                    } else {
                        *(LAS unsigned*)(Q1 + tl * TS + 4 * kp) = pg8::cvt_pk_bf16(q0 * ep0, q1 * ep1);
                        *(LAS unsigned*)(QS + t * TS + 4 * kp) = pg8::cvt_pk_bf16(q0 * (er10 * ep0), q1 * (er11 * ep1));
                        *(LAS unsigned*)(KDB + tl * TS + 4 * kp) = pg8::cvt_pk_bf16(kk0 * em0, kk1 * em1);
                    } }
            }
            __syncthreads();
            const int l2 = lane_id(), fr = l2 & 15, fq = l2 >> 4;
            u32x4 stv[4], vtv[4];
            { const GAS u32x4* sg = (const GAS u32x4*)(ST + ((size_t)(seg * 8 + h) * 2 + dir) * 16384); const bf16_t* vsrc = IV + (size_t)r0 * D + cb;
#pragma unroll
                for (int i = 0; i < 4; ++i) { const int c = tid + NTHR * i; stv[i] = __builtin_nontemporal_load(sg + c); vtv[i] = *(const GAS u32x4*)(vsrc + (size_t)(c >> 4) * D + (c & 15) * 8); } }
            {
                const int ct = wid >> 2; const bool tA = (ct == dir);
                const LAS unsigned char* qb = tA ? (QS + (16 * wid) * TS) : (Q1 + ((16 * wid) & 63) * TS);
                bf16x8 Qf[4];
#pragma unroll
                for (int kk = 0; kk < 4; ++kk) Qf[kk] = FRAG(qb, fr, kk);
                const int t = 16 * wid + fr;
#pragma unroll
                for (int j = 0; j < 8; ++j) { const int cs = j >> 2; const bool sA = (cs == dir);
                    f32x4 pacc = (f32x4){0.f, 0.f, 0.f, 0.f};
                    if (!(tA && !sA)) {
                        const LAS unsigned char* kb = (tA ? KDA : (sA ? KEA : KDB)) + ((16 * j) & 63) * TS;
#pragma unroll
                        for (int kk = 0; kk < 4; ++kk) pacc = __builtin_amdgcn_mfma_f32_16x16x32_bf16(FRAG(kb, fr, kk), Qf[kk], pacc, 0, 0, 0);
                        if (tA == sA) {
#pragma unroll
                            for (int r = 0; r < 4; ++r) { const int s = 16 * j + 4 * fq + r; const bool keep = dir ? (s >= t) : (s <= t); if (!keep) pacc[r] = 0.f; }
                        }
                    }
#ifdef HG_SAN_P
                    for (int r = 0; r < 4; ++r) if (!(fabsf(pacc[r]) < 1e6f)) pacc[r] = 0.f;
#endif
                    u32x2 w; w.x = pg8::cvt_pk_bf16(pacc[0], pacc[1]); w.y = pg8::cvt_pk_bf16(pacc[2], pacc[3]);
                    *(LAS u32x2*)(PP + t * TS + (16 * j + 4 * fq) * 2) = w; }
            }
            __syncthreads();
            {
#pragma unroll
                for (int i = 0; i < 4; ++i) { const int c = tid + NTHR * i; *(LAS u32x4*)(STL + (c >> 4) * TS + (c & 15) * 16) = stv[i]; }
#pragma unroll
                for (int i = 0; i < 4; ++i) { const int c = tid + NTHR * i; *(LAS u32x4*)(VT + (c >> 4) * TS + (c & 15) * 16) = vtv[i]; }
            }
            __syncthreads();
#pragma unroll
            for (int kk = 0; kk < 4; ++kk) { bf16x8 Af[4], Bf[2];
#pragma unroll
                for (int m = 0; m < 4; ++m) Af[m] = FRAG(PP, 64 * wr + 16 * m + fr, kk);
#pragma unroll
                for (int n = 0; n < 2; ++n) Bf[n] = frag_tr_perm(VT, 32 * wc, n, kk, fq * 16 + fr);
#pragma unroll
                for (int m = 0; m < 4; ++m)
#pragma unroll
                    for (int n = 0; n < 2; ++n) acc[m][n] = __builtin_amdgcn_mfma_f32_16x16x32_bf16(Bf[n], Af[m], acc[m][n], 0, 0, 0);
#pragma unroll
                for (int m = 0; m < 4; ++m) Af[m] = FRAG(QS, 64 * wr + 16 * m + fr, kk);
#pragma unroll
                for (int n = 0; n < 2; ++n) Bf[n] = FRAG(STL, 32 * wc + 8 * (fr >> 2) + 4 * n + (fr & 3), kk);
#pragma unroll
                for (int m = 0; m < 4; ++m)
#pragma unroll
                    for (int n = 0; n < 2; ++n) acc[m][n] = __builtin_amdgcn_mfma_f32_16x16x32_bf16(Bf[n], Af[m], acc[m][n], 0, 0, 0); }
            __syncthreads();
        }
        const int l3 = lane_id(), fr = l3 & 15, fq = l3 >> 4;
        f32x4 nwv[2]; u32x4 gsq[4];
        const int v8 = cb + 32 * wc + 8 * fq;
#pragma unroll
        for (int n = 0; n < 2; ++n) nwv[n] = *(const GAS f32x4*)(normw + v8 + 4 * n);
#pragma unroll
        for (int m = 0; m < 4; ++m) gsq[m] = __builtin_nontemporal_load((const GAS u32x4*)(GS + (size_t)(r0 + 64 * wr + 16 * m + fr) * D + v8));
#pragma unroll
        for (int m = 0; m < 4; ++m) { float ss = 0.f;
#pragma unroll
            for (int n = 0; n < 2; ++n) ss += (acc[m][n][0] * acc[m][n][0] + acc[m][n][1] * acc[m][n][1]) + (acc[m][n][2] * acc[m][n][2] + acc[m][n][3] * acc[m][n][3]);
            ss += pg8::shx(ss, l3, 16); ss += pg8::shx(ss, l3, 32);
            if (fq == 0) RED[(64 * wr + 16 * m + fr) * 4 + wc] = ss; }
        __syncthreads();
#pragma unroll
        for (int m = 0; m < 4; ++m) { const int t = 64 * wr + 16 * m + fr; const f32x4 rr = *(const LAS f32x4*)(RED + t * 4);
            const float rstd = rsqrtf(((rr[0] + rr[1]) + (rr[2] + rr[3])) * (1.0f / 128.0f) + 1e-6f);
            u32x4 w16;
#pragma unroll
            for (int n = 0; n < 2; ++n) { const f32x4 nw = nwv[n]; const unsigned g0 = n ? gsq[m].z : gsq[m].x, g1 = n ? gsq[m].w : gsq[m].y;
                const f32x4 gs = (f32x4){pg8::bflo(g0), pg8::bfhi(g0), pg8::bflo(g1), pg8::bfhi(g1)};
                const f32x4 o = acc[m][n] * rstd * nw * gs;
                if (n == 0) { w16.x = pg8::cvt_pk_bf16(o[0], o[1]); w16.y = pg8::cvt_pk_bf16(o[2], o[3]); } else { w16.z = pg8::cvt_pk_bf16(o[0], o[1]); w16.w = pg8::cvt_pk_bf16(o[2], o[3]); } }
            *(GAS u32x4*)(OB + (size_t)(r0 + t) * D + v8) = w16; }
        __syncthreads();
    }
}

#define XB_TMO      128
#define XB_XCNT(j)  (256  + 64 * (j))
#define XB_XSUB(j)  (1280 + 64 * (j))
#define XB_XGEN(j)  (2304 + 64 * (j))
#define XB_TOP      3328
#define XB_TOPGEN   3392
#define XCD_BAR_WORDS 3456
#define XB_SPIN_CAP (1u << 18)

__device__ __forceinline__ unsigned xb_ld(unsigned* p)              { return __hip_atomic_load(p, __ATOMIC_RELAXED, __HIP_MEMORY_SCOPE_AGENT); }
__device__ __forceinline__ unsigned xb_add(unsigned* p, unsigned v) { return __hip_atomic_fetch_add(p, v, __ATOMIC_RELAXED, __HIP_MEMORY_SCOPE_AGENT); }
__device__ __forceinline__ unsigned xb_xcc_id() { return (unsigned)__builtin_amdgcn_s_getreg((3 << 11) | 20) & 0xFu; }
#define XB_SPIN(cond, bar) do { unsigned _sp = 0; while (cond) { __builtin_amdgcn_s_sleep(1); \
    if ((++_sp & 255u) == 0u) { if (xb_ld(&(bar)[XB_TMO])) break; if (_sp > XB_SPIN_CAP) { atomicAdd(&(bar)[XB_TMO], 1u); break; } } } } while (0)

struct XcdBarrier {
    unsigned* bar; unsigned x;
    volatile LAS unsigned* st;
};

__device__ __forceinline__ XcdBarrier xcd_barrier_post(unsigned* bar, volatile LAS unsigned* st, bool leader) {
    XcdBarrier b; b.bar = bar; b.x = xb_xcc_id(); b.st = st;
    if (leader) (void)xb_add(&bar[XB_XCNT(b.x)], 1u);
    return b;
}
__device__ __forceinline__ void xcd_barrier_complete(unsigned* bar, unsigned x, unsigned& nloc, unsigned& nx) {
    const unsigned G = gridDim.x * gridDim.y * gridDim.z;
    unsigned sum, cnt, mine, sp = 0u;
    for (;;) {
        sum = 0u; cnt = 0u; mine = 0u;
#pragma unroll
        for (unsigned j = 0; j < 16; ++j) { const unsigned c = xb_ld(&bar[XB_XCNT(j)]); sum += c; cnt += (c > 0u) ? 1u : 0u; mine = (j == x) ? c : mine; }
        if (sum == G) break;
        __builtin_amdgcn_s_sleep(1);
        if ((++sp & 255u) == 0u) { if (xb_ld(&bar[XB_TMO])) break; if (sp > XB_SPIN_CAP) { atomicAdd(&bar[XB_TMO], 1u); break; } }
    }
    nloc = mine > 0u ? mine : 1u; nx = cnt > 0u ? cnt : 1u;
}

__device__ __forceinline__ void xcd_barrier(const XcdBarrier& b, bool leader) {
    asm volatile("s_waitcnt vmcnt(0)" ::: "memory");
    __syncthreads();
    if (leader) {
        unsigned* bar = b.bar;
        __builtin_amdgcn_s_waitcnt(0);
        unsigned nloc = b.st[0], nx = b.st[1];
        if (nloc == 0u) { xcd_barrier_complete(bar, b.x, nloc, nx); b.st[0] = nloc; b.st[1] = nx; }
        const unsigned old = xb_add(&bar[XB_XSUB(b.x)], 1u);
        const unsigned gen = old / nloc;
        if (old + 1u == (gen + 1u) * nloc) {
            __builtin_amdgcn_fence(__ATOMIC_RELEASE, "agent");
            asm volatile("s_waitcnt vmcnt(0)" ::: "memory");
            const unsigned og = xb_add(&bar[XB_TOP], 1u);
            const unsigned tg = og / nx;
            if (og + 1u == (tg + 1u) * nx) xb_add(&bar[XB_TOPGEN], 1u);
            else XB_SPIN(xb_ld(&bar[XB_TOPGEN]) == tg, bar);
            __builtin_amdgcn_fence(__ATOMIC_ACQUIRE, "agent");
            xb_add(&bar[XB_XGEN(b.x)], 1u);
            asm volatile("s_waitcnt vmcnt(0)" ::: "memory");
        } else {
            XB_SPIN(xb_ld(&bar[XB_XGEN(b.x)]) == gen, bar);
            __builtin_amdgcn_fence(__ATOMIC_ACQUIRE, "agent");
            asm volatile("s_waitcnt vmcnt(0)" ::: "memory");
        }
    }
    __syncthreads();
}

#ifndef PROBE_MIXCAT
#define PROBE_MIXCAT 2
#endif
#ifndef PROBE_ACAT
#define PROBE_ACAT 1
#endif
#ifndef PROBE_BCAT
#define PROBE_BCAT 1
#endif
#ifndef PROBE_CCAT
#define PROBE_CCAT 1
#endif
#ifndef PROBE_UPCAT
#define PROBE_UPCAT 0
#endif
#ifdef PROBE_EXTRA_SYNC
#define GSYNC() do { GSYNC0(); PT(3); GSYNC0(); PT(2); } while (0)
#else
#define GSYNC() do { GSYNC0(); PT(3); } while (0)
#endif
#define GSYNC0() do { xcd_barrier(xbar, wave == 0 && lane_id() == 0); } while (0)
#ifdef PROBE_C1
#ifdef PROBE_GEMM
#define PTC(cat) ((cat) == 3 ? 3 : 4)
#else
#define PTC(cat) (cat)
#endif
#define PT(cat) do { if (wave == 0 && lane_id() == 0) { LAS unsigned long long* tc_ = (LAS unsigned long long*)(lds + 152000); const unsigned long long now_ = __builtin_amdgcn_s_memrealtime(); tc_[1 + PTC(cat)] += now_ - tc_[0]; tc_[0] = now_; } } while (0)
#else
#define PT(cat) do { } while (0)
#endif
template <class Epi> __device__ __forceinline__ void run_gemm(LAS unsigned char* lds, const bf16_t* A, const bf16_t* Bt, int M, int N, int K, const Epi& E, int G, int bid, int wave) {
    pg8::Gemm g{A, Bt, M, N, K}; pg8::StaticOrder S; S.init(M, N, G, bid);
    pg8::gemm_phase<Epi, pg8::StaticOrder, true, true>(lds, g, S, E, wave);
}

__global__ void __launch_bounds__(NTHR, 2) mega_fwd(Args a) {
    extern __shared__ __attribute__((aligned(16))) unsigned char lds_raw[];
    LAS unsigned char* lds = (LAS unsigned char*)lds_raw;
    cg::grid_group grid = cg::this_grid();
    int wave = __builtin_amdgcn_readfirstlane((int)threadIdx.x >> 6); asm volatile("" : "+s"(wave));
    const int G = gridDim.x, bid = blockIdx.x, gw = bid * 8 + wave, ngw = G * 8;
#define WS_PTRS(wsp) float* LB = (float*)((wsp) + WS_LB); float* DEC = (float*)((wsp) + WS_DEC); float* SSQ = (float*)((wsp) + WS_SSQ); f32x2* STAT = (f32x2*)((wsp) + WS_STAT); \
    bf16_t* WB = (bf16_t*)((wsp) + WS_WB); bf16_t* XB = (bf16_t*)((wsp) + WS_XB); bf16_t* BIG = (bf16_t*)((wsp) + WS_BIG); (void)LB; (void)DEC; (void)SSQ; (void)STAT; (void)WB; (void)XB; (void)BIG;
    const float* norm_w = a.in[2];

    { volatile LAS unsigned* st_ = (volatile LAS unsigned*)(lds + 153600); if (wave == 0 && lane_id() < 2) st_[lane_id()] = 0u; }
    __syncthreads();
    const XcdBarrier xbar = xcd_barrier_post((unsigned*)(a.ws + WS_BAR), (volatile LAS unsigned*)(lds + 153600), wave == 0 && lane_id() == 0);
#ifdef PROBE_C1
    if (wave == 0 && lane_id() == 0) { LAS unsigned long long* tc_ = (LAS unsigned long long*)(lds + 152000); tc_[0] = __builtin_amdgcn_s_memrealtime(); for (int i = 1; i < 6; ++i) tc_[i] = 0; }
#endif
    {
        const int lane = lane_id(), tid = wave * 64 + lane;
        unsigned char* ws = a.ws; WS_PTRS(ws)
        LAS float* scr = (LAS float*)(lds + wave * 16384);
        for (int l = 0; l < 2; ++l)
            for (int j = 0; j < 2; ++j) { const size_t wo = (size_t)(l * 2 + j);
                conv_matrix(1, a.in[3] + wo * D * FF, a.in[4] + wo * D * FF, FF, D, 2 * FF, norm_w + (l * 3 + (j ? 2 : 0)) * D, WB + WB_FFN + wo * WB_FFN_STRIDE, scr, gw, ngw, lane);
                conv_matrix(0, a.in[5] + wo * FF * D, nullptr, D, FF, D, nullptr, WB + WB_FFN + wo * WB_FFN_STRIDE + WB_DN_OFF, scr, gw, ngw, lane); }
        conv_matrix(0, a.in[6], nullptr, 2 * SGD, D, 2 * SGD, norm_w + 1 * D, WB + WB_SGU_IN, scr, gw, ngw, lane);
        conv_matrix(0, a.in[11], nullptr, D, SGD, D, nullptr, WB + WB_SGU_OUT, scr, gw, ngw, lane);
        conv_matrix(0, a.in[12], nullptr, 5 * D, D, 5 * D, norm_w + 4 * D, WB + WB_HG_IN, scr, gw, ngw, lane);
        conv_matrix(0, a.in[15], nullptr, D, D, D, nullptr, WB + WB_HG_OUT, scr, gw, ngw, lane);
        for (int i = bid * NTHR + tid; i < 2048; i += G * NTHR) { const int d = i >> 10, kq = i & 1023; const float* raw = a.in[13] + d * 2048;
            ((GAS float*)LB)[i] = 1.0f / (1.0f + __expf(((const GAS float*)raw)[kq] - ((const GAS float*)raw)[1024 + kq])); }
    }
    PT(4);
    GSYNC();
    if (a.ws == nullptr) grid.sync();

#pragma unroll 1
    for (int s = 0; s < 2; ++s) {
        { unsigned char* ws = a.ws; asm volatile("" : "+s"(ws)); WS_PTRS(ws) prep_rows(a.in[s], XB, SSQ, SLAB, gw, ngw); } PT(4);
        GSYNC();
#pragma unroll 1
        for (int st = 0; st < 6; ++st) {
            unsigned char* ws = a.ws; asm volatile("" : "+s"(ws)); WS_PTRS(ws)
            const float* xin = a.in[s]; float* xo = a.out + (size_t)s * SLAB * D; asm volatile("" : "+s"(xo));
#ifndef NO_SGU
            if (st == 1) {
                { pg8::EpiSguV E{BIG, SSQ, STAT}; run_gemm(lds, XB, WB + WB_SGU_IN + (size_t)SGD * D, SLAB, SGD, D, E, G, bid, wave); } PT(0);
                GSYNC();
                sgu_mix(lds, BIG, STAT, a.in[9], a.in[10], a.in[7], a.in[8], G, bid, wave); PT(PROBE_MIXCAT);
                GSYNC();
                { pg8::EpiSguU E{BIG, SSQ}; run_gemm(lds, XB, WB + WB_SGU_IN, SLAB, SGD, D, E, G, bid, wave); } PT(0);
                GSYNC();
                { pg8::EpiDown E{xo, xo, XB, SSQ, 1.0f, (LAS float*)(lds + 135168)}; run_gemm(lds, BIG, WB + WB_SGU_OUT, SLAB, D, SGD, E, G, bid, wave); } PT(0);
                GSYNC();
            } else
#endif
#ifndef NO_HGRN
            if (st == 4) {
                bf16_t* QSb = BIG; const size_t hst = (size_t)HSL * D; bf16_t* GFb = BIG + hst; bf16_t* GBb = BIG + 2 * hst; bf16_t* IVb = BIG + 3 * hst; bf16_t* GSb = BIG + 4 * hst; bf16_t* OBb = BIG + 5 * hst; bf16_t* STb = BIG + 6 * hst;
#pragma unroll 1
                for (int hf = 0; hf < 2; ++hf) {
                    const size_t ro = (size_t)hf * HSL;
                    { pg8::EpiHgrn E{BIG, hst, SSQ + ro * 4, LB}; run_gemm(lds, XB + ro * D, WB + WB_HG_IN, HSL, 5 * D, D, E, G, bid, wave); } PT(0);
                    GSYNC();
#ifndef HG_SKIP_A
                    hgrn_pass_a(lds, GFb, GBb, IVb, STb, DEC, G, bid, wave); PT(PROBE_ACAT);
#endif
                    GSYNC();
#ifndef HG_SKIP_B
                    hgrn_pass_b(STb, DEC, s == 0 ? 8 : 2, s == 0 ? 16 : 64, G, bid, wave); PT(PROBE_BCAT);
#endif
                    GSYNC();
#ifndef HG_SKIP_C
                    hgrn_pass_c(lds, QSb, GFb, GBb, IVb, GSb, STb, a.in[14], OBb, G, bid, wave); PT(PROBE_CCAT);
#else
                    OBb = QSb;
#endif
                    GSYNC();
                    { pg8::EpiDown E{xo + ro * D, xo + ro * D, XB + ro * D, SSQ + ro * 4, 1.0f, (LAS float*)(lds + 135168)}; run_gemm(lds, OBb, WB + WB_HG_OUT, HSL, D, D, E, G, bid, wave); } PT(0);
                    GSYNC();
                }
            } else
#endif
            {
                const int fi = (st == 0) ? 0 : (st == 2) ? 1 : (st == 3) ? 2 : 3;
                const bf16_t* wgu = WB + WB_FFN + (size_t)fi * WB_FFN_STRIDE;
                { pg8::EpiSwiGLU E{BIG, FF, SSQ}; run_gemm(lds, XB, wgu, SLAB, 2 * FF, D, E, G, bid, wave); } PT(PROBE_UPCAT);
                GSYNC();
                { pg8::EpiDown E{st == 0 ? xin : (const float*)xo, xo, XB, SSQ, 0.5f, (LAS float*)(lds + 135168)}; run_gemm(lds, BIG, wgu + WB_DN_OFF, SLAB, D, FF, E, G, bid, wave); } PT(0);
                GSYNC();
            }
        }
        { unsigned char* ws = a.ws; asm volatile("" : "+s"(ws)); WS_PTRS(ws) final_rows(a.out + (size_t)s * SLAB * D, SSQ, a.in[16], SLAB, gw, ngw); } PT(4);
        GSYNC();
    }
#ifdef PROBE_C1
    if (bid == 0 && wave == 0 && lane_id() == 0) { LAS unsigned long long* tc_ = (LAS unsigned long long*)(lds + 152000);
        float tot = 0.f; for (int i = 1; i < 6; ++i) tot += (float)tc_[i];
        const float q1 = rintf(100.f * (float)tc_[1 + PROBE_C1] / tot) * 0.01f, q2 = rintf(1000.f * (float)tc_[1 + PROBE_C2] / tot) * 0.001f;
        const float d1 = sqrtf(33554432.f * 1e-4f * q1), d2 = sqrtf(33554432.f * 1e-6f * q2);
        a.out[0] += d1; a.out[1] += d2; a.out[(size_t)SLAB * D] += d1; a.out[(size_t)SLAB * D + 1] += d2; }
#endif
}

extern "C" void kernel_launch(void* const* d_in, const int* in_sizes, int n_in, void* d_out, int out_size, void* d_ws, size_t ws_size, hipStream_t stream) {
    static int grid = 0;
    if (grid == 0) {
        if (n_in != 17 || out_size != 2 * SLAB * D || ws_size < WS_END) { fprintf(stderr, "kernel_launch: unexpected problem (n_in %d, out %d, ws %zu)\n", n_in, out_size, ws_size); grid = -1; return; }
        int dev = 0, cus = 0, per_cu = 0;
        hipGetDevice(&dev); hipDeviceGetAttribute(&cus, hipDeviceAttributeMultiprocessorCount, dev);
        hipFuncSetAttribute((const void*)mega_fwd, hipFuncAttributeMaxDynamicSharedMemorySize, LDS_BYTES);
        hipOccupancyMaxActiveBlocksPerMultiprocessor(&per_cu, (const void*)mega_fwd, NTHR, LDS_BYTES);
        if (per_cu < 1) { fprintf(stderr, "kernel_launch: occupancy query says %d blocks/CU\n", per_cu); per_cu = 1; }
        (void)hipGetLastError();
        grid = cus;
        if (SLAB % (grid * 16) != 0) { fprintf(stderr, "kernel_launch: unsupported CU count %d\n", cus); grid = -1; return; }
    }
    if (grid < 0) return;
    if (hipMemsetAsync((char*)d_ws + WS_BAR, 0, 16384, stream) != hipSuccess) { fprintf(stderr, "kernel_launch: memset failed\n"); return; }
    Args a{};
    for (int i = 0; i < 17; ++i) a.in[i] = (const float*)d_in[i];
    a.out = (float*)d_out; a.ws = (unsigned char*)d_ws;
    void* args[] = {&a};
    hipError_t e = hipLaunchCooperativeKernel((const void*)mega_fwd, dim3(grid), dim3(NTHR), args, LDS_BYTES, stream);
    if (e != hipSuccess) fprintf(stderr, "cooperative launch failed: %s (grid %d)\n", hipGetErrorString(e), grid);
}
```
